# Optimizing an MI355X kernel written in HIP

```python
import jax, jax.numpy as jnp
from jax import lax
import numpy as np

D_MODEL = 1024
BATCH = 4
SEQ = 4096
DEPTH = 1

GRID_W = 64
CTX_LEN = 256
HEAD_DIM = 64
N_HEADS = 16
N_KV_HEADS = 4
GROUP = N_HEADS // N_KV_HEADS
Q_W = N_HEADS * HEAD_DIM
KV_W = N_KV_HEADS * HEAD_DIM
WINDOW = 128
BLOCK = 128
ROPE_THETA = 10000.0
POOL_WINDOWS = (2, 4, 8, 16)
POOL_GROUPS = 4
POOL_W = D_MODEL // 2
POOL_GROUP_W = POOL_W // POOL_GROUPS
N_BRANCHES = 2
REST_START = Q_W + 2 * KV_W
IN_W = REST_START + POOL_W + N_BRANCHES * D_MODEL
D_FF = ((8 * D_MODEL // 3 + 255) // 256) * 256
N_MOD = 6
EPS = 1e-6

kernel_name = 'hybrid_pool_swa_flow_block'


def rms_norm(x, g):
    xf = x.astype(jnp.float32)
    y = xf * lax.rsqrt(jnp.mean(xf * xf, axis=-1, keepdims=True) + EPS)
    return (y * g.astype(jnp.float32)).astype(x.dtype)


def modulate(x, shift, scale):
    return x * (1 + scale) + shift


def heads(t, n):
    return t.reshape(*t.shape[:-1], n, HEAD_DIM)


def axial_rope_tables(seq):
    rows = seq // GRID_W
    row, col = jnp.meshgrid(jnp.arange(rows), jnp.arange(GRID_W), indexing='ij')
    row = row.reshape(-1).astype(jnp.float32)
    col = col.reshape(-1).astype(jnp.float32)
    half = HEAD_DIM // 2
    inv_freq = 1.0 / (ROPE_THETA ** (jnp.arange(0, half, 2, dtype=jnp.float32) / half))
    ang = jnp.stack([row[:, None] * inv_freq, col[:, None] * inv_freq], axis=1)
    return jnp.cos(ang), jnp.sin(ang)


def apply_axial_rope(x, cos, sin):
    B, S, H, _ = x.shape
    xa = x.astype(jnp.float32).reshape(B, S, H, 2, HEAD_DIM // 2)
    x1, x2 = jnp.split(xa, 2, axis=-1)
    c = cos[None, :, None]
    s = sin[None, :, None]
    out = jnp.concatenate([x1 * c - x2 * s, x2 * c + x1 * s], axis=-1)
    return out.reshape(B, S, H, HEAD_DIM).astype(x.dtype)


def band_mask(nb):
    i = jnp.arange(BLOCK)[:, None]
    j = jnp.arange(3 * BLOCK)[None, :]
    rel = j - BLOCK - i
    kpos = (jnp.arange(nb)[:, None, None] - 1) * BLOCK + j[None]
    return (jnp.abs(rel)[None] <= WINDOW) & (kpos >= 0) & (kpos < nb * BLOCK)


def window_attention(q, k, v, kc, vc, sink):
    B, S = q.shape[:2]
    nb = S // BLOCK
    scale = HEAD_DIM ** -0.5
    qb = q.reshape(B, nb, BLOCK, N_KV_HEADS, GROUP, HEAD_DIM)

    def neighbours(t):
        tp = jnp.pad(t, ((0, 0), (BLOCK, BLOCK), (0, 0), (0, 0)))
        tp = tp.reshape(B, nb + 2, BLOCK, N_KV_HEADS, HEAD_DIM)
        return jnp.concatenate([tp[:, :-2], tp[:, 1:-1], tp[:, 2:]], axis=2)

    kw, vw = neighbours(k), neighbours(v)
    s_win = jnp.einsum('bnqkgd,bnjkd->bkgnqj', qb, kw, preferred_element_type=jnp.float32) * scale
    s_win = jnp.where(band_mask(nb)[None, None, None], s_win, -jnp.inf)
    s_ctx = jnp.einsum('bnqkgd,bckd->bkgnqc', qb, kc, preferred_element_type=jnp.float32) * scale
    sink_l = sink.astype(jnp.float32).reshape(1, N_KV_HEADS, GROUP, 1, 1, 1)
    m = jnp.maximum(jnp.maximum(s_win.max(-1, keepdims=True), s_ctx.max(-1, keepdims=True)), sink_l)
    p_win = jnp.exp(s_win - m)
    p_ctx = jnp.exp(s_ctx - m)
    den = p_win.sum(-1, keepdims=True) + p_ctx.sum(-1, keepdims=True) + jnp.exp(sink_l - m)
    o = (jnp.einsum('bkgnqj,bnjkd->bkgnqd', p_win, vw.astype(jnp.float32))
         + jnp.einsum('bkgnqc,bckd->bkgnqd', p_ctx, vc.astype(jnp.float32))) / den
    o = o.transpose(0, 3, 4, 1, 2, 5).reshape(B, S, Q_W)
    return o.astype(q.dtype)


def context_attention(qc, kc, vc, sink):
    B, C = qc.shape[:2]
    qg = qc.reshape(B, C, N_KV_HEADS, GROUP, HEAD_DIM)
    s = jnp.einsum('bqkgd,bckd->bkgqc', qg, kc, preferred_element_type=jnp.float32) * HEAD_DIM ** -0.5
    sink_col = jnp.broadcast_to(sink.astype(jnp.float32).reshape(1, N_KV_HEADS, GROUP, 1, 1), s.shape[:-1] + (1,))
    p = jax.nn.softmax(jnp.concatenate([s, sink_col], axis=-1), axis=-1)[..., :C]
    o = jnp.einsum('bkgqc,bckd->bqkgd', p, vc.astype(jnp.float32))
    return o.reshape(B, C, Q_W).astype(qc.dtype)


def multiscale_pool(u, pool_w, pool_scale):
    B, S, _ = u.shape
    ug = u.astype(jnp.float32).reshape(B, S, POOL_GROUPS, POOL_GROUP_W)
    cs = jnp.pad(jnp.cumsum(ug, axis=1), ((0, 0), (1, 0), (0, 0), (0, 0)))
    t = jnp.arange(S)
    pooled = []
    for g, w in enumerate(POOL_WINDOWS):
        lo = jnp.clip(t - w // 2, 0, S)
        hi = jnp.clip(t + w // 2, 0, S)
        cs_g = cs[:, :, g, :]
        win_sum = cs_g[:, hi] - cs_g[:, lo]
        pooled.append(win_sum / (hi - lo).astype(jnp.float32)[None, :, None])
    diff = jnp.stack(pooled, axis=2) - ug
    mixed = jnp.einsum('bsgc,gcd->bsgd', diff, pool_w.astype(jnp.float32))
    return (mixed.reshape(B, S, POOL_W) * pool_scale).astype(u.dtype)


def merge_branches(attn, rest, gate_b, pool_w, pool_scale, w_attn_proj, w_pool_proj, w_out):
    pool_in, gate_logits = rest[..., :POOL_W], rest[..., POOL_W:]
    a = attn @ w_attn_proj
    p = multiscale_pool(pool_in, pool_w, pool_scale) @ w_pool_proj
    ga, gp = jnp.split(jax.nn.sigmoid(gate_logits + gate_b), N_BRANCHES, axis=-1)
    return (ga * a + gp * p) @ w_out


def swiglu_sublayer(x, shift, scale, gate, g, w_up, w_down):
    h = modulate(rms_norm(x, g), shift, scale)
    a, b = jnp.split(h @ w_up, 2, axis=-1)
    return x + gate * ((jax.nn.silu(a) * b) @ w_down)


def setup_inputs(seed: int = 0) -> dict:
    key = jax.random.key(seed)
    ks = jax.random.split(key, 20)

    def nrm(k, shape, s):
        return jax.random.normal(k, shape, jnp.float32) * s

    D, L = D_MODEL, DEPTH
    return {
        'x': nrm(ks[0], (BATCH, SEQ, D), 1.0),
        'c': nrm(ks[1], (BATCH, D), 1.0),
        'ctx': nrm(ks[2], (BATCH, CTX_LEN, D), 1.0),
        'c_ctx': nrm(ks[3], (D,), 1.0),
        'mod_w': nrm(ks[4], (L, D, N_MOD * D), 0.5 * D ** -0.5),
        'mod_b': nrm(ks[5], (L, N_MOD * D), 0.01),
        'norm1_g': 1.0 + nrm(ks[6], (L, D), 0.05),
        'norm2_g': 1.0 + nrm(ks[7], (L, D), 0.05),
        'w_in': nrm(ks[8], (L, D, IN_W), D ** -0.5),
        'gate_b': nrm(ks[9], (L, N_BRANCHES * D), 0.02),
        'q_norm_g': 1.0 + nrm(ks[10], (L, HEAD_DIM), 0.05),
        'k_norm_g': 1.0 + nrm(ks[11], (L, HEAD_DIM), 0.05),
        'sink': nrm(ks[12], (L, N_HEADS), 0.5),
        'pool_w': nrm(ks[13], (L, POOL_GROUPS, POOL_GROUP_W, POOL_GROUP_W), POOL_GROUP_W ** -0.5),
        'pool_scale': 1.0 + nrm(ks[14], (L, POOL_W), 0.1),
        'w_attn_proj': nrm(ks[15], (L, Q_W, D), Q_W ** -0.5),
        'w_pool_proj': nrm(ks[16], (L, POOL_W, D), POOL_W ** -0.5),
        'w_out': nrm(ks[17], (L, D, D), D ** -0.5),
        'w_up': nrm(ks[18], (L, D, 2 * D_FF), D ** -0.5),
        'w_down': nrm(ks[19], (L, D_FF, D), D_FF ** -0.5),
    }


def reference(x, c, ctx, c_ctx, mod_w, mod_b, norm1_g, norm2_g, w_in, gate_b, q_norm_g, k_norm_g,
              sink, pool_w, pool_scale, w_attn_proj, w_pool_proj, w_out, w_up, w_down):
    cos, sin = axial_rope_tables(x.shape[1])
    for l in range(DEPTH):
        mod_x = jax.nn.silu(c) @ mod_w[l] + mod_b[l]
        mod_c = jax.nn.silu(c_ctx) @ mod_w[l] + mod_b[l]
        sh1, sc1, g1, sh2, sc2, g2 = jnp.split(mod_x[:, None, :], N_MOD, axis=-1)
        csh1, csc1, cg1, csh2, csc2, cg2 = jnp.split(mod_c, N_MOD)

        hc = modulate(rms_norm(ctx, norm1_g[l]), csh1, csc1)
        kv_c = hc @ w_in[l][:, Q_W:REST_START]
        kc = rms_norm(heads(kv_c[..., :KV_W], N_KV_HEADS), k_norm_g[l])
        vc = heads(kv_c[..., KV_W:], N_KV_HEADS)

        h = modulate(rms_norm(x, norm1_g[l]), sh1, sc1)
        proj = h @ w_in[l]
        q = apply_axial_rope(rms_norm(heads(proj[..., :Q_W], N_HEADS), q_norm_g[l]), cos, sin)
        k = apply_axial_rope(rms_norm(heads(proj[..., Q_W:Q_W + KV_W], N_KV_HEADS), k_norm_g[l]), cos, sin)
        v = heads(proj[..., Q_W + KV_W:REST_START], N_KV_HEADS)
        attn = window_attention(q, k, v, kc, vc, sink[l])
        mix = merge_branches(attn, proj[..., REST_START:], gate_b[l], pool_w[l], pool_scale[l],
                             w_attn_proj[l], w_pool_proj[l], w_out[l])
        x_next = x + g1 * mix
        x_next = swiglu_sublayer(x_next, sh2, sc2, g2, norm2_g[l], w_up[l], w_down[l])

        if l + 1 < DEPTH:
            q_c = rms_norm(heads(hc @ w_in[l][:, :Q_W], N_HEADS), q_norm_g[l])
            attn_c = context_attention(q_c, kc, vc, sink[l])
            mix_c = merge_branches(attn_c, hc @ w_in[l][:, REST_START:], gate_b[l], pool_w[l], pool_scale[l],
                                   w_attn_proj[l], w_pool_proj[l], w_out[l])
            ctx = ctx + cg1 * mix_c
            ctx = swiglu_sublayer(ctx, csh2, csc2, cg2, norm2_g[l], w_up[l], w_down[l])
        x = x_next
    return x
```

```cpp
#include <hip/hip_runtime.h>
#include <cstdio>
#include <cstdint>

typedef unsigned short bf16_t;
typedef unsigned u32x4 __attribute__((ext_vector_type(4)));
typedef unsigned u32x2 __attribute__((ext_vector_type(2)));
typedef float f32x4 __attribute__((ext_vector_type(4)));

constexpr int NB = 4, SEQ = 4096, DM = 1024, MTOK = NB * SEQ, CTX = 256, MCTX = NB * CTX;
constexpr int INW = 4096, FF = 2816, NUP = 2 * FF, POOLW = 512, KVW = 256, NMOD = 6 * DM;
constexpr float EPS = 1e-6f, LOG2E = 1.4426950408889634f, QSCALE = 0.125f * LOG2E;

constexpr size_t MiB = 1u << 20;
constexpr size_t WS_WIN = 1 * MiB, WS_WAP = 9 * MiB, WS_WOUT = 12 * MiB, WS_WUP = 14 * MiB, WS_WDN = 25 * MiB;
constexpr size_t WS_PW = 31 * MiB, WS_MOD = 31 * MiB + 256 * 1024, WS_B2 = 31 * MiB + 512 * 1024;
constexpr size_t WS_H = 32 * MiB, WS_Q = 66 * MiB, WS_K = 98 * MiB, WS_VT = 106 * MiB, WS_KC = 114 * MiB, WS_VCT = 114 * MiB + 512 * 1024;
constexpr size_t WS_POOLIN = 115 * MiB, WS_GATES = 131 * MiB, WS_PM = 195 * MiB  , WS_SSQ = 227 * MiB, WS_WPP = 229 * MiB  ;
constexpr size_t WS_PG = 66 * MiB;
constexpr int PMP = 1024;
constexpr size_t WS_ATT = 32 * MiB  , WS_Y2 = 32 * MiB, WS_ACT = 66 * MiB, WS_DIFF = 98 * MiB  ;

struct Ptrs {
    const float *x, *c, *ctx, *c_ctx, *mod_w, *mod_b, *n1g, *n2g, *w_in, *gate_b, *qg, *kg, *sink, *pool_w, *pool_scale, *w_ap, *w_pp, *w_out, *w_up, *w_dn;
    float* out; unsigned char* ws;
};

__device__ __forceinline__ float bf2f(bf16_t v) { return __uint_as_float((unsigned)v << 16); }
__device__ __forceinline__ unsigned f2bf(float f) { unsigned u = __float_as_uint(f); return (u + 0x7fffu + ((u >> 16) & 1u)) >> 16; }
__device__ __forceinline__ unsigned pk2(float lo, float hi) { return f2bf(lo) | (f2bf(hi) << 16); }
__device__ __forceinline__ void unpack8(u32x4 w, float (&v)[8]) {
    v[0] = __uint_as_float(w.x << 16); v[1] = __uint_as_float(w.x & 0xffff0000u); v[2] = __uint_as_float(w.y << 16); v[3] = __uint_as_float(w.y & 0xffff0000u);
    v[4] = __uint_as_float(w.z << 16); v[5] = __uint_as_float(w.z & 0xffff0000u); v[6] = __uint_as_float(w.w << 16); v[7] = __uint_as_float(w.w & 0xffff0000u);
}
typedef float f32x2_t __attribute__((ext_vector_type(2))); typedef __bf16 bf16x2_t __attribute__((ext_vector_type(2)));
__device__ __forceinline__ unsigned cvtpk(float lo, float hi) { f32x2_t v = {lo, hi}; bf16x2_t b = __builtin_convertvector(v, bf16x2_t); return __builtin_bit_cast(unsigned, b); }
__device__ __forceinline__ u32x4 pack8(const float (&v)[8]) { u32x4 w; w.x = cvtpk(v[0], v[1]); w.y = cvtpk(v[2], v[3]); w.z = cvtpk(v[4], v[5]); w.w = cvtpk(v[6], v[7]); return w; }
__device__ __forceinline__ float sigmoidf_(float v) { return __builtin_amdgcn_rcpf(1.0f + __builtin_amdgcn_exp2f(-LOG2E * v)); }
__device__ __forceinline__ float siluf_(float v) { return v * __builtin_amdgcn_rcpf(1.0f + __builtin_amdgcn_exp2f(-LOG2E * v)); }
__device__ __forceinline__ int perm16(int t) { return (t & ~12) | ((t & 4) << 1) | ((t & 8) >> 1); }
__device__ __forceinline__ float wave_sum(float v) {
#pragma unroll
    for (int o = 1; o < 64; o <<= 1) v += __shfl_xor(v, o);
    return v;
}
__host__ __device__ __forceinline__ int qk_pos(int j) { const int f = j & 15; return 8 * (f >> 2) + (j < 16 ? 0 : 4) + (f & 3); }
__host__ __device__ __forceinline__ int qk_row(int tile, int hd, int d) { return tile * 256 + 128 * (d >> 5) + 32 * hd + qk_pos(d & 31); }
__host__ __device__ __forceinline__ int up_src_col(int np) { const int tile = np >> 8, r = np & 255; return r < 128 ? tile * 128 + r : FF + tile * 128 + (r - 128); }

struct EpiInRest {
    bf16_t *Vt, *POOLIN, *GATES; const float* gate_b;
    __device__ __forceinline__ void operator()(int row, int c0, const float (&v)[8]) const {
        if (c0 < 1536) {
            const int b = row >> 12, t = row & 4095, cv = c0 - 1280, kh = cv >> 6, d0 = cv & 63;
            bf16_t* p = Vt + ((size_t)((b * 4 + kh) * 64 + d0)) * SEQ + perm16(t);
#pragma unroll
            for (int i = 0; i < 8; ++i) p[(size_t)i * SEQ] = (bf16_t)f2bf(v[i]);
        } else if (c0 < 2048) {
            *(u32x4*)(POOLIN + (size_t)row * POOLW + (c0 - 1536)) = pack8(v);
        } else {
            const int s = c0 - 2048, gc = ((s >> 7) & 1) * 1024 + ((s >> 8) << 7) + (s & 127); float g[8];
#pragma unroll
            for (int i = 0; i < 8; ++i) g[i] = sigmoidf_(v[i] + gate_b[gc + i]);
            *(u32x4*)(GATES + (size_t)row * 2048 + gc) = pack8(g);
        }
    }
};
struct EpiCtxV {
    bf16_t* Vct;
    __device__ __forceinline__ void operator()(int row, int c0, const float (&v)[8]) const {
        const int b = row >> 8, t = row & 255, kh = c0 >> 6, d0 = c0 & 63;
        bf16_t* p = Vct + ((size_t)((b * 4 + kh) * 64 + d0)) * CTX + perm16(t);
#pragma unroll
        for (int i = 0; i < 8; ++i) p[(size_t)i * CTX] = (bf16_t)f2bf(v[i]);
    }
};
struct EpiPoolMix {
    bf16_t* PM; const float* pool_scale; int g;
    __device__ __forceinline__ void operator()(int row, int c0, const float (&v)[8]) const {
        float o[8];
#pragma unroll
        for (int i = 0; i < 8; ++i) o[i] = v[i] * pool_scale[g * 128 + c0 + i];
        *(u32x4*)(PM + (size_t)row * PMP + g * 128 + c0) = pack8(o);
    }
};
struct EpiPoolProj {
    bf16_t* PG; const bf16_t* GATES;
    __device__ __forceinline__ void operator()(int row, int c0, const float (&v)[8]) const {
        float g[8], o[8]; unpack8(*(const u32x4*)(GATES + (size_t)row * 2048 + 1024 + c0), g);
#pragma unroll
        for (int i = 0; i < 8; ++i) o[i] = g[i] * v[i];
        *(u32x4*)(PG + (size_t)row * DM + c0) = pack8(o);
    }
};
struct EpiAttnProj {
    bf16_t* PG; const bf16_t* GATES;
    __device__ __forceinline__ void operator()(int row, int c0, const float (&v)[8]) const {
        float g[8], p[8], o[8]; unpack8(*(const u32x4*)(GATES + (size_t)row * 2048 + c0), g); unpack8(*(const u32x4*)(PG + (size_t)row * DM + c0), p);
#pragma unroll
        for (int i = 0; i < 8; ++i) o[i] = g[i] * v[i] + p[i];
        *(u32x4*)(PG + (size_t)row * DM + c0) = pack8(o);
    }
};
struct EpiOut {
    const float* x; float* out; bf16_t* Y2; const float* mod; const float* n2g;
    __device__ __forceinline__ float operator()(int row, int c0, const float (&v)[8]) const {
        const int b = row >> 12; const float* mb = mod + (size_t)b * NMOD; float o[8], y[8], ss = 0.f;
#pragma unroll
        for (int h = 0; h < 2; ++h) {
            const f32x4 xv = *(const f32x4*)(x + (size_t)row * DM + c0 + 4 * h), g1 = *(const f32x4*)(mb + 2 * DM + c0 + 4 * h), sc2 = *(const f32x4*)(mb + 4 * DM + c0 + 4 * h), ng = *(const f32x4*)(n2g + c0 + 4 * h);
#pragma unroll
            for (int i = 0; i < 4; ++i) { const float x1 = xv[i] + g1[i] * v[4 * h + i]; o[4 * h + i] = x1; ss += x1 * x1; y[4 * h + i] = x1 * (ng[i] * (1.0f + sc2[i])); }
            *(f32x4*)(out + (size_t)row * DM + c0 + 4 * h) = (f32x4){o[4 * h], o[4 * h + 1], o[4 * h + 2], o[4 * h + 3]};
        }
        *(u32x4*)(Y2 + (size_t)row * DM + c0) = pack8(y);
        return ss;
    }
};
struct EpiUp {
    bf16_t* ACT; const float* bias2;
    __device__ __forceinline__ void operator()(int row, int c0, float rstd, const float (&va)[8], const float (&vb)[8]) const {
        const int b = row >> 12, np = ((c0 >> 7) << 8) + (c0 & 127); const float* bb = bias2 + (size_t)b * NUP + np; float o[8];
#pragma unroll
        for (int i = 0; i < 8; ++i) { const float a = rstd * va[i] + bb[i], g = rstd * vb[i] + bb[128 + i]; o[i] = siluf_(a) * g; }
        *(u32x4*)(ACT + (size_t)row * FF + c0) = pack8(o);
    }
};
struct EpiDown {
    float* out; const float* mod; float* dump = nullptr;
    __device__ __forceinline__ void operator()(int row, int c0, const float (&v)[8]) const {
        const int b = row >> 12; const float* g2 = mod + (size_t)b * NMOD + 5 * DM + c0;
#pragma unroll
        for (int h = 0; h < 2; ++h) { f32x4 xv = *(const f32x4*)(out + (size_t)row * DM + c0 + 4 * h); const f32x4 g = *(const f32x4*)(g2 + 4 * h);
#pragma unroll
            for (int i = 0; i < 4; ++i) xv[i] += g[i] * v[4 * h + i];
            if (dump) *(f32x4*)(dump + (((size_t)row * DM + c0 + 4 * h) & (size_t)0x7fffff)) = xv; else *(f32x4*)(out + (size_t)row * DM + c0 + 4 * h) = xv; }
    }
};
__device__ __forceinline__ float row_rstd(const float* SSQ, int row) {
    const f32x4 v = *(const f32x4*)(SSQ + (size_t)row * 4);
    return __builtin_amdgcn_rsqf(((v[0] + v[1]) + (v[2] + v[3])) * (1.0f / DM) + EPS);
}

__device__ __forceinline__ void h_row(const float* xrow, const float* g, const float* sh, const float* sc, bf16_t* orow, int lane) {
    const f32x4* xr = (const f32x4*)xrow + lane; f32x4 v[4]; float s = 0.f;
#pragma unroll
    for (int j = 0; j < 4; ++j) { v[j] = xr[64 * j]; s += (v[j][0] * v[j][0] + v[j][1] * v[j][1]) + (v[j][2] * v[j][2] + v[j][3] * v[j][3]); }
    const float rstd = 1.0f / sqrtf(wave_sum(s) * (1.0f / DM) + EPS);
#pragma unroll
    for (int j = 0; j < 4; ++j) {
        const f32x4 gg = ((const f32x4*)g + lane)[64 * j], s1 = ((const f32x4*)sh + lane)[64 * j], c1 = ((const f32x4*)sc + lane)[64 * j]; float o[4];
#pragma unroll
        for (int i = 0; i < 4; ++i) o[i] = (v[j][i] * rstd * gg[i]) * (1.0f + c1[i]) + s1[i];
        u32x2 w; w.x = pk2(o[0], o[1]); w.y = pk2(o[2], o[3]);
        ((u32x2*)orow + lane)[64 * j] = w;
    }
}
__device__ __forceinline__ void bias2_row(const bf16_t* wrow, const float* mod, float* bias2, int np, int lane) {
    float w[16]; { float t[8]; unpack8(*(const u32x4*)(wrow + lane * 16), t);
#pragma unroll
        for (int i = 0; i < 8; ++i) w[i] = t[i];
        unpack8(*(const u32x4*)(wrow + lane * 16 + 8), t);
#pragma unroll
        for (int i = 0; i < 8; ++i) w[8 + i] = t[i]; }
#pragma unroll
    for (int b = 0; b < 4; ++b) { const float* sh2 = mod + (size_t)b * NMOD + 3 * DM + lane * 16; float s = 0.f;
#pragma unroll
        for (int i = 0; i < 16; ++i) s += sh2[i] * w[i];
        s = wave_sum(s); if (lane == 0) bias2[(size_t)b * NUP + np] = s; }
}

__global__ void k_transpose(const float* W, int K, int N, bf16_t* WT, int upmode) {
    const size_t total = (size_t)K * N;
    for (size_t idx = (size_t)blockIdx.x * blockDim.x + threadIdx.x; idx < total; idx += (size_t)gridDim.x * blockDim.x) {
        const int np = (int)(idx / K), k = (int)(idx % K); const int n = upmode ? up_src_col(np) : np;
        WT[idx] = (bf16_t)f2bf(W[(size_t)k * N + n]);
    }
}
__global__ void k_mod(Ptrs P) {
    const int idx = blockIdx.x * blockDim.x + threadIdx.x; if (idx >= 5 * NMOD) return;
    const int r = idx / NMOD, n = idx % NMOD; const float* cv = r < 4 ? P.c + (size_t)r * DM : P.c_ctx; float s = 0.f;
    for (int k = 0; k < DM; ++k) s += siluf_(cv[k]) * P.mod_w[(size_t)k * NMOD + n];
    ((float*)(P.ws + WS_MOD))[idx] = s + P.mod_b[n];
}
__global__ void k_rows(Ptrs P) {
    const int gw = (blockIdx.x * blockDim.x + threadIdx.x) >> 6, nw = (gridDim.x * blockDim.x) >> 6, lane = threadIdx.x & 63;
    const float* mod = (const float*)(P.ws + WS_MOD); bf16_t* H = (bf16_t*)(P.ws + WS_H);
    for (int m = gw; m < MTOK + MCTX; m += nw) {
        const float* xr = m < MTOK ? P.x + (size_t)m * DM : P.ctx + (size_t)(m - MTOK) * DM; const float* mb = mod + (size_t)(m < MTOK ? (m >> 12) : 4) * NMOD;
        h_row(xr, P.n1g, mb, mb + DM, H + (size_t)m * DM, lane);
    }
    for (int np = gw; np < NUP; np += nw) bias2_row((const bf16_t*)(P.ws + WS_WUP) + (size_t)np * DM, mod, (float*)(P.ws + WS_B2), np, lane);
}
template <class Epi> __global__ void k_gemm(const bf16_t* A, int lda, const bf16_t* Bt, int ldb, int Mrows, int N, int K, int col_off, Epi E) {
    const int gw = (blockIdx.x * blockDim.x + threadIdx.x) >> 6, lane = threadIdx.x & 63, nrb = Mrows / 64;
    if (gw >= nrb * (N / 8)) return;
    const int row = (gw % nrb) * 64 + lane, c0 = (gw / nrb) * 8;
    float acc[8];
#pragma unroll
    for (int j = 0; j < 8; ++j) acc[j] = 0.f;
    for (int k0 = 0; k0 < K; k0 += 8) {
        float a[8]; unpack8(*(const u32x4*)(A + (size_t)row * lda + k0), a);
#pragma unroll
        for (int j = 0; j < 8; ++j) { float b[8]; unpack8(*(const u32x4*)(Bt + (size_t)(c0 + j) * ldb + k0), b);
#pragma unroll
            for (int i = 0; i < 8; ++i) acc[j] += a[i] * b[i]; }
    }
    E(row, c0 + col_off, acc);
}
__global__ void k_gemm_out(const bf16_t* A, const bf16_t* Bt, EpiOut E) {
    const int gw = (blockIdx.x * blockDim.x + threadIdx.x) >> 6, lane = threadIdx.x & 63, nrb = MTOK / 64;
    if (gw >= nrb * (DM / 8)) return;
    const int row = (gw % nrb) * 64 + lane, c0 = (gw / nrb) * 8;
    float acc[8];
#pragma unroll
    for (int j = 0; j < 8; ++j) acc[j] = 0.f;
    for (int k0 = 0; k0 < DM; k0 += 8) {
        float a[8]; unpack8(*(const u32x4*)(A + (size_t)row * DM + k0), a);
#pragma unroll
        for (int j = 0; j < 8; ++j) { float b[8]; unpack8(*(const u32x4*)(Bt + (size_t)(c0 + j) * DM + k0), b);
#pragma unroll
            for (int i = 0; i < 8; ++i) acc[j] += a[i] * b[i]; }
    }
    (void)E(row, c0, acc);
}
__global__ void k_ssq(const float* out, float* SSQ) {
    const int idx = blockIdx.x * blockDim.x + threadIdx.x; if (idx >= MTOK * 4) return;
    const float* p = out + (size_t)(idx >> 2) * DM + (idx & 3) * 256; float s = 0.f;
    for (int i = 0; i < 256; ++i) s += p[i] * p[i];
    SSQ[idx] = s;
}
__global__ void k_gemm_up(const bf16_t* A, const bf16_t* Bt, const float* SSQ, EpiUp E) {
    const int gw = (blockIdx.x * blockDim.x + threadIdx.x) >> 6, lane = threadIdx.x & 63, nrb = MTOK / 64;
    if (gw >= nrb * (FF / 8)) return;
    const int row = (gw % nrb) * 64 + lane, c0 = (gw / nrb) * 8, np = ((c0 >> 7) << 8) + (c0 & 127);
    float aa[8], ab[8];
#pragma unroll
    for (int j = 0; j < 8; ++j) { aa[j] = 0.f; ab[j] = 0.f; }
    for (int k0 = 0; k0 < DM; k0 += 8) {
        float a[8]; unpack8(*(const u32x4*)(A + (size_t)row * DM + k0), a);
#pragma unroll
        for (int j = 0; j < 8; ++j) { float b[8]; unpack8(*(const u32x4*)(Bt + (size_t)(np + j) * DM + k0), b);
#pragma unroll
            for (int i = 0; i < 8; ++i) aa[j] += a[i] * b[i];
            unpack8(*(const u32x4*)(Bt + (size_t)(np + 128 + j) * DM + k0), b);
#pragma unroll
            for (int i = 0; i < 8; ++i) ab[j] += a[i] * b[i]; }
    }
    E(row, c0, row_rstd(SSQ, row), aa, ab);
}
__global__ void __launch_bounds__(256) k_qk(Ptrs P, int ctxmode) {
    const int gw = (blockIdx.x * blockDim.x + threadIdx.x) >> 6, lane = threadIdx.x & 63;
    const int nrows = ctxmode ? MCTX : MTOK, nrb = nrows / 64, nheads = ctxmode ? 4 : 20;
    if (gw >= nrb * nheads) return;
    const int row = (gw % nrb) * 64 + lane, hh = gw / nrb;
    const bool isq = !ctxmode && hh < 16; const int wtile = (ctxmode || hh >= 16) ? 4 : hh >> 2, whd = hh & 3;
    const bf16_t* A = (const bf16_t*)(P.ws + WS_H) + (size_t)(ctxmode ? MTOK + row : row) * DM; const bf16_t* Bt = (const bf16_t*)(P.ws + WS_WIN);
    float acc[64];
#pragma unroll
    for (int j = 0; j < 64; ++j) acc[j] = 0.f;
    for (int k0 = 0; k0 < DM; k0 += 8) {
        float a[8]; unpack8(*(const u32x4*)(A + k0), a);
#pragma unroll
        for (int j = 0; j < 64; ++j) { float b[8]; unpack8(*(const u32x4*)(Bt + (size_t)qk_row(wtile, whd, j) * DM + k0), b);
#pragma unroll
            for (int i = 0; i < 8; ++i) acc[j] += a[i] * b[i]; }
    }
    float ss = 0.f;
#pragma unroll
    for (int j = 0; j < 64; ++j) ss += acc[j] * acc[j];
    const float rstd = 1.0f / sqrtf(ss * (1.0f / 64.0f) + EPS); const float* g = isq ? P.qg : P.kg;
#pragma unroll
    for (int j = 0; j < 64; ++j) acc[j] = acc[j] * rstd * g[j];
    bf16_t* dst;
    if (ctxmode) dst = (bf16_t*)(P.ws + WS_KC) + (size_t)row * KVW + hh * 64;
    else {
        const int t = row & 4095;
#pragma unroll
        for (int a = 0; a < 2; ++a) { const float pos = (float)(a ? (t & 63) : (t >> 6));
#pragma unroll
            for (int f = 0; f < 16; ++f) { const float ang = pos * exp2f(-(float)f * (13.287712379549449f / 16.0f)); float sn, cs; sincosf(ang, &sn, &cs);
                const float x1 = acc[32 * a + f], x2 = acc[32 * a + 16 + f]; acc[32 * a + f] = x1 * cs - x2 * sn; acc[32 * a + 16 + f] = x2 * cs + x1 * sn; } }
        if (isq) {
#pragma unroll
            for (int j = 0; j < 64; ++j) acc[j] *= QSCALE;
            dst = (bf16_t*)(P.ws + WS_Q) + (size_t)row * DM + hh * 64;
        } else dst = (bf16_t*)(P.ws + WS_K) + (size_t)row * KVW + (hh - 16) * 64;
    }
#pragma unroll
    for (int j = 0; j < 64; j += 8) { float o[8];
#pragma unroll
        for (int i = 0; i < 8; ++i) o[i] = acc[j + i];
        *(u32x4*)(dst + j) = pack8(o); }
}
__global__ void __launch_bounds__(256) k_attn(Ptrs P) {
    const int gw = (blockIdx.x * blockDim.x + threadIdx.x) >> 6, lane = threadIdx.x & 63, nrb = MTOK / 64;
    if (gw >= nrb * 16) return;
    const int row = (gw % nrb) * 64 + lane, h = gw / nrb, kh = h >> 2, b = row >> 12, t = row & 4095;
    bf16_t* Qp = (bf16_t*)(P.ws + WS_Q) + (size_t)row * DM + h * 64;
    const bf16_t* Kb = (const bf16_t*)(P.ws + WS_K) + (size_t)b * SEQ * KVW + kh * 64; const bf16_t* Vb = (const bf16_t*)(P.ws + WS_VT) + (size_t)(b * 4 + kh) * 64 * SEQ;
    const bf16_t* Kc = (const bf16_t*)(P.ws + WS_KC) + (size_t)b * CTX * KVW + kh * 64; const bf16_t* Vc = (const bf16_t*)(P.ws + WS_VCT) + (size_t)(b * 4 + kh) * 64 * CTX;
    float q[64], o[64];
#pragma unroll
    for (int j = 0; j < 64; j += 8) { float tq[8]; unpack8(*(const u32x4*)(Qp + j), tq);
#pragma unroll
        for (int i = 0; i < 8; ++i) { q[j + i] = tq[i]; o[j + i] = 0.f; } }
    const float sink2 = P.sink[h] * LOG2E; float m = sink2;
    const int jlo = t - 128 < 0 ? 0 : t - 128, jhi = t + 128 > SEQ - 1 ? SEQ - 1 : t + 128;
    for (int pass = 0; pass < 2; ++pass) {
        float den = 0.f;
        for (int kk = jlo; kk <= jhi + CTX; ++kk) {
            const bool isc = kk > jhi; const int j = isc ? kk - jhi - 1 : kk; const bf16_t* kp = isc ? Kc + (size_t)j * KVW : Kb + (size_t)j * KVW;
            float s = 0.f;
#pragma unroll
            for (int d8 = 0; d8 < 64; d8 += 8) { float kv[8]; unpack8(*(const u32x4*)(kp + d8), kv);
#pragma unroll
                for (int i = 0; i < 8; ++i) s += q[d8 + i] * kv[i]; }
            if (pass == 0) m = fmaxf(m, s);
            else { const float p = exp2f(s - m); den += p; const bf16_t* vp = isc ? Vc + perm16(j) : Vb + perm16(j); const int pitch = isc ? CTX : SEQ;
#pragma unroll
                for (int d = 0; d < 64; ++d) o[d] += p * bf2f(vp[(size_t)d * pitch]); }
        }
        if (pass == 1) { den += exp2f(sink2 - m); const float inv = 1.0f / den;
#pragma unroll
            for (int j = 0; j < 64; j += 8) { float w[8];
#pragma unroll
                for (int i = 0; i < 8; ++i) w[i] = o[j + i] * inv;
                *(u32x4*)((bf16_t*)(P.ws + WS_ATT) + (size_t)row * DM + h * 64 + j) = pack8(w); } }
    }
}
__global__ void k_diff(const bf16_t* POOLIN, bf16_t* DIFF) {
    const int idx = blockIdx.x * blockDim.x + threadIdx.x; if (idx >= MTOK * POOLW) return;
    const int row = idx / POOLW, ch = idx % POOLW, g = ch >> 7, w2 = 1 << g, t = row & 4095, base = row - t;
    const int lo = t - w2 < 0 ? 0 : t - w2, hi = t + w2 > SEQ ? SEQ : t + w2; float s = 0.f;
    for (int j = lo; j < hi; ++j) s += bf2f(POOLIN[(size_t)(base + j) * POOLW + ch]);
    DIFF[idx] = (bf16_t)f2bf(s / (float)(hi - lo) - bf2f(POOLIN[idx]));
}


#include <hip/hip_cooperative_groups.h>
namespace cg = cooperative_groups;
#define LAS __attribute__((address_space(3)))
#define LDS_WAIT() asm volatile("s_waitcnt lgkmcnt(0)" ::: "memory")
constexpr int NWAVES = 8, NTHR = NWAVES * 64;
constexpr int LDS_BYTES = 147456 + 256;
constexpr int RING_BYTES = 131072;

#ifndef MK_HI
#define MK_HI 8
#endif
#ifndef MK_LO
#define MK_LO 0
#endif
#ifndef MK_DBL
#define MK_DBL -1
#endif
#ifndef MK_SYNCX
#define MK_SYNCX 0
#endif
struct MkArgs { Ptrs P; int ph_lo, ph_hi; };

__device__ __forceinline__ void p0_transpose_item(const float* W, int K, int N, bf16_t* WT, int upmode, LAS float* scr, int item, int lane, int ldo = 0, bool qkperm = false) {
    ldo = ldo ? ldo : K;
    const int nblk = N / 32, kb = item / nblk, nb = item % nblk, k0 = 64 * kb, n0 = 32 * nb;
#pragma unroll 8
    for (int i = 0; i < 32; ++i) { const int kk = 2 * i + (lane >> 5); scr[kk * 33 + (lane & 31)] = __builtin_nontemporal_load(W + (size_t)(k0 + kk) * N + n0 + (lane & 31)); }
    LDS_WAIT(); asm volatile("" ::: "memory");
    int r0 = n0;
    if (upmode) r0 = n0 < FF ? ((n0 >> 7) << 8) + (n0 & 127) : (((n0 - FF) >> 7) << 8) + 128 + ((n0 - FF) & 127);
    const int c = lane & 7;
#pragma unroll
    for (int j = 0; j < 4; ++j) { const int n = (lane >> 3) + 8 * j; const LAS float* s = scr + (8 * c) * 33 + n;
        u32x4 o; o.x = pk2(s[0 * 33], s[1 * 33]); o.y = pk2(s[2 * 33], s[3 * 33]); o.z = pk2(s[4 * 33], s[5 * 33]); o.w = pk2(s[6 * 33], s[7 * 33]);
        int rowd = r0 + n;
        if (qkperm && n0 < 1280) rowd = (n0 & ~255) + 128 * ((n0 >> 5) & 1) + 32 * ((n0 >> 6) & 3) + qk_pos(n);
        else if (qkperm && n0 >= 2048) { const int gcol = n0 - 2048 + n, half = gcol >> 10, c = gcol & 1023; rowd = 2048 + ((c >> 7) << 8) + 128 * half + (c & 127); }
        *(u32x4*)(WT + (size_t)rowd * ldo + k0 + 8 * c) = o; }
    LDS_WAIT(); asm volatile("" ::: "memory");
}

__device__ __forceinline__ void mk_p0(const Ptrs& P, LAS unsigned char* lds, int tid, int wave, int lane, int bx, int G) {
    unsigned char* ws = P.ws;
    LAS float* scr = (LAS float*)(lds + wave * 16384);
    const int gw = bx * NWAVES + wave, NGW = G * NWAVES;
    constexpr int I_IN = (DM / 64) * (INW / 32), I_AP = (DM / 64) * (DM / 32), I_PP = (POOLW / 64) * (DM / 32), I_OUT = I_AP, I_UP = (DM / 64) * (NUP / 32), I_DN = (FF / 64) * (DM / 32), I_PW = 4 * 2 * 4;
    constexpr int NITEMS = I_IN + I_AP + I_PP + I_OUT + I_UP + I_DN + I_PW;
    for (int it = gw; it < NITEMS; it += NGW) {
        int r = it;
        if (r < I_IN) { p0_transpose_item(P.w_in, DM, INW, (bf16_t*)(ws + WS_WIN), 0, scr, r, lane, 0, true); continue; } r -= I_IN;
        if (r < I_AP) { p0_transpose_item(P.w_ap, DM, DM, (bf16_t*)(ws + WS_WAP), 0, scr, r, lane); continue; } r -= I_AP;
        if (r < I_PP) { p0_transpose_item(P.w_pp, POOLW, DM, (bf16_t*)(ws + WS_WPP), 0, scr, r, lane, PMP); continue; } r -= I_PP;
        if (r < I_OUT) { p0_transpose_item(P.w_out, DM, DM, (bf16_t*)(ws + WS_WOUT), 0, scr, r, lane); continue; } r -= I_OUT;
        if (r < I_UP) { p0_transpose_item(P.w_up, DM, NUP, (bf16_t*)(ws + WS_WUP), 1, scr, r, lane); continue; } r -= I_UP;
        if (r < I_DN) { p0_transpose_item(P.w_dn, FF, DM, (bf16_t*)(ws + WS_WDN), 0, scr, r, lane); continue; } r -= I_DN;
        { const int g = r >> 3; p0_transpose_item(P.pool_w + g * 16384, 128, 128, (bf16_t*)(ws + WS_PW) + g * 16384, 0, scr, r & 7, lane); }
    }
    for (int cgp = bx; cgp < NMOD / 32; cgp += G) {
        LAS float* sl = (LAS float*)(lds + RING_BYTES);
        __syncthreads();
        sl = (LAS float*)lds;
        LAS float* red = (LAS float*)(lds + 32768);
        for (int i = tid; i < 5 * DM; i += NTHR) { const int r = i >> 10, k = i & 1023; sl[i] = siluf_(r < 4 ? P.c[(size_t)r * DM + k] : P.c_ctx[k]); }
        __syncthreads();
        const int col = lane & 31, half = lane >> 5; float acc[5] = {0.f, 0.f, 0.f, 0.f, 0.f};
        const float* wp = P.mod_w + (size_t)(128 * wave + half) * NMOD + 32 * cgp + col;
#pragma unroll 8
        for (int i = 0; i < 64; ++i) { const float wv = __builtin_nontemporal_load(wp + (size_t)(2 * i) * NMOD); const int k = 128 * wave + 2 * i + half;
#pragma unroll
            for (int r = 0; r < 5; ++r) acc[r] += sl[r * DM + k] * wv; }
#pragma unroll
        for (int r = 0; r < 5; ++r) red[((wave * 2 + half) * 5 + r) * 32 + col] = acc[r];
        __syncthreads();
        if (tid < 160) { const int r = tid >> 5, c = tid & 31; float s = 0.f;
#pragma unroll
            for (int p = 0; p < 16; ++p) s += red[(p * 5 + r) * 32 + c];
            ((float*)(ws + WS_MOD))[(size_t)r * NMOD + 32 * cgp + c] = s + P.mod_b[32 * cgp + c]; }
        __syncthreads();
    }
}
template <int NR> __device__ __forceinline__ void h_rows(const float* xbase, const f32x4 (&A)[4], const f32x4 (&Bv)[4], bf16_t* obase, int lane) {
    f32x4 v[NR][4]; float s[NR];
#pragma unroll
    for (int r = 0; r < NR; ++r)
#pragma unroll
        for (int j = 0; j < 4; ++j) v[r][j] = __builtin_nontemporal_load((const f32x4*)(xbase + (size_t)r * DM) + lane + 64 * j);
#pragma unroll
    for (int r = 0; r < NR; ++r) { s[r] = 0.f;
#pragma unroll
        for (int j = 0; j < 4; ++j) s[r] += (v[r][j][0] * v[r][j][0] + v[r][j][1] * v[r][j][1]) + (v[r][j][2] * v[r][j][2] + v[r][j][3] * v[r][j][3]); }
#pragma unroll
    for (int o = 1; o < 64; o <<= 1)
#pragma unroll
        for (int r = 0; r < NR; ++r) s[r] += __shfl_xor(s[r], o);
#pragma unroll
    for (int r = 0; r < NR; ++r) { const float rs = __builtin_amdgcn_rsqf(s[r] * (1.0f / DM) + EPS);
#pragma unroll
        for (int j = 0; j < 4; ++j) { u32x2 w; w.x = cvtpk(v[r][j][0] * rs * A[j][0] + Bv[j][0], v[r][j][1] * rs * A[j][1] + Bv[j][1]); w.y = cvtpk(v[r][j][2] * rs * A[j][2] + Bv[j][2], v[r][j][3] * rs * A[j][3] + Bv[j][3]);
            ((u32x2*)(obase + (size_t)r * DM) + lane)[64 * j] = w; } }
}
__device__ __forceinline__ void h_factors(const float* g, const float* sh, const float* sc, f32x4 (&A)[4], f32x4 (&Bv)[4], int lane) {
#pragma unroll
    for (int j = 0; j < 4; ++j) { const f32x4 gg = ((const f32x4*)g + lane)[64 * j], c1 = ((const f32x4*)sc + lane)[64 * j]; Bv[j] = ((const f32x4*)sh + lane)[64 * j];
#pragma unroll
        for (int i = 0; i < 4; ++i) A[j][i] = gg[i] * (1.0f + c1[i]); }
}
template <int NP> __device__ __forceinline__ void bias2_rows(const bf16_t* WUP, const float* mod, float* bias2, int np0, int stride, int lane) {
    u32x4 wraw[NP][2];
#pragma unroll
    for (int p = 0; p < NP; ++p) { const int np = np0 + p * stride < NUP ? np0 + p * stride : np0; wraw[p][0] = *(const u32x4*)(WUP + (size_t)np * DM + lane * 16); wraw[p][1] = *(const u32x4*)(WUP + (size_t)np * DM + lane * 16 + 8); }
    float acc[NP][4];
#pragma unroll
    for (int p = 0; p < NP; ++p)
#pragma unroll
        for (int b = 0; b < 4; ++b) acc[p][b] = 0.f;
#pragma unroll
    for (int b = 0; b < 4; ++b) { const float* sh2 = mod + (size_t)b * NMOD + 3 * DM + lane * 16; float sv[16];
#pragma unroll
        for (int q = 0; q < 4; ++q) { const f32x4 t = *(const f32x4*)(sh2 + 4 * q); sv[4 * q] = t[0]; sv[4 * q + 1] = t[1]; sv[4 * q + 2] = t[2]; sv[4 * q + 3] = t[3]; }
#pragma unroll
        for (int p = 0; p < NP; ++p) { float w[8];
            unpack8(wraw[p][0], w);
#pragma unroll
            for (int i = 0; i < 8; ++i) acc[p][b] += sv[i] * w[i];
            unpack8(wraw[p][1], w);
#pragma unroll
            for (int i = 0; i < 8; ++i) acc[p][b] += sv[8 + i] * w[i]; } }
#pragma unroll
    for (int o = 1; o < 64; o <<= 1)
#pragma unroll
        for (int p = 0; p < NP; ++p)
#pragma unroll
            for (int b = 0; b < 4; ++b) acc[p][b] += __shfl_xor(acc[p][b], o);
    if (lane == 0) {
#pragma unroll
        for (int p = 0; p < NP; ++p) if (np0 + p * stride < NUP) {
#pragma unroll
            for (int b = 0; b < 4; ++b) bias2[(size_t)b * NUP + np0 + p * stride] = acc[p][b]; } }
}
__device__ __forceinline__ void mk_p1(const Ptrs& P, int wave, int lane, int bx, int G) {
    const int gw = bx * NWAVES + wave, NGW = G * NWAVES;
    const float* mod = (const float*)(P.ws + WS_MOD); bf16_t* H = (bf16_t*)(P.ws + WS_H);
    f32x4 A[4], Bv[4];
    for (int m0 = gw * 8; m0 < MTOK; m0 += NGW * 8) { const float* mb = mod + (size_t)(m0 >> 12) * NMOD; h_factors(P.n1g, mb, mb + DM, A, Bv, lane);
        h_rows<4>(P.x + (size_t)m0 * DM, A, Bv, H + (size_t)m0 * DM, lane); h_rows<4>(P.x + (size_t)(m0 + 4) * DM, A, Bv, H + (size_t)(m0 + 4) * DM, lane); }
    for (int m0 = gw * 2; m0 < MCTX; m0 += NGW * 2) { const float* mb = mod + (size_t)4 * NMOD; h_factors(P.n1g, mb, mb + DM, A, Bv, lane); h_rows<2>(P.ctx + (size_t)m0 * DM, A, Bv, H + (size_t)(MTOK + m0) * DM, lane); }
    for (int np = gw; np < NUP; np += 3 * NGW) bias2_rows<3>((const bf16_t*)(P.ws + WS_WUP), mod, (float*)(P.ws + WS_B2), np, NGW, lane);
}

namespace pg8 {
#define PG8_LAS __attribute__((address_space(3)))
typedef unsigned short bf16_t;
typedef short bf16x8 __attribute__((ext_vector_type(8)));
typedef float f32x4 __attribute__((ext_vector_type(4)));
typedef unsigned u32x4 __attribute__((ext_vector_type(4)));
constexpr int BM = 256, BK = 64, HALF = 128, HTB = HALF * BK * 2  , STAGE_BYTES = 8 * HTB, NXCD = 8, WGM = 8;

__host__ __device__ __forceinline__ int lds_byte(int r, int c) { const int st = (r >> 4) * 2 + (c >> 5), rr = r & 15, cc = c & 31, ob = rr * 64 + cc * 2; return st * 1024 + (ob ^ (((ob >> 9) & 1) << 5)); }
__host__ __device__ __forceinline__ void stage_rc(int b, int& R, int& C) { const int st = b / 1024, sb = b % 1024, swz = sb ^ (((sb >> 9) & 1) << 5); R = (st >> 1) * 16 + swz / 64; C = (st & 1) * 32 + (swz % 64) / 2; }
__host__ __device__ __forceinline__ int perm32(int rho) { const int n = rho >> 4, i = rho & 15; return 8 * (i >> 2) + 4 * n + (i & 3); }

struct Unit { int pm, pn, seg; };
struct Gemm { const bf16_t* A; const bf16_t* Bt; int M, N, K; const bf16_t* A0 = nullptr; const bf16_t* Bt0 = nullptr; int K0 = 0; };
template <class E> struct TwoSeg { static constexpr bool v = false; };

struct StaticOrder {
    int nM, nN, nwg, G, c;
    __host__ __device__ void init(int M, int N, int G_, int c_) { nM = M / BM; nN = N / BM; nwg = nM * nN; G = G_; c = c_; }
    __host__ __device__ bool next(int i, Unit& u) const {
        const long L = (long)i * G + c; if (L >= nwg) return false;
        int wgid = (int)L; { const int q = nwg / NXCD, r = nwg % NXCD, xcd = wgid % NXCD, off = wgid / NXCD; wgid = (xcd < r ? xcd * (q + 1) : r * (q + 1) + (xcd - r) * q) + off; }
        const int nig = WGM * nN, gid = wgid / nig, fm = gid * WGM, gsz = (nM - fm) < WGM ? (nM - fm) : WGM;
        u.pm = fm + ((wgid % nig) % gsz); u.pn = (wgid % nig) / gsz; u.seg = 0; return true;
    }
    __device__ __forceinline__ void a_ready(const Unit&) const {}
    __device__ __forceinline__ void done(const Unit&) const {}
};

__device__ __forceinline__ unsigned cvt_pk_bf16(float lo, float hi) { unsigned r; asm volatile("v_cvt_pk_bf16_f32 %0, %1, %2" : "=v"(r) : "v"(lo), "v"(hi)); return r; }
template <class Epi, class Sched, bool ALIGN_EPI = false, bool SP2 = false>
__device__ __forceinline__ void gemm_phase(PG8_LAS unsigned char* lds, const Gemm g, const Sched& S, const Epi& E) {
    const int tid = threadIdx.x, wid = __builtin_amdgcn_readfirstlane(tid >> 6), lane = tid & 63, wr = wid >> 2, wc = wid & 3, fr = lane & 15, fq = lane >> 4;
    const int K = g.K, nt1 = K / BK, nt0 = g.K0 ? g.K0 / BK : nt1;
    unsigned voffA[2], voffB[2];
#pragma unroll
    for (int i = 0; i < 2; ++i) { int R, C; stage_rc(tid * 16 + i * 8192, R, C); const int Rb = Epi::PERM ? ((R & ~31) + perm32(R & 31)) : R;
        voffA[i] = (unsigned)(R * K + C) * 2u; voffB[i] = (unsigned)(Rb * K + C) * 2u; }
    const size_t kstep = (size_t)(BK * 2);
    const size_t hstep = (size_t)HALF * K * 2;
    const size_t tstep = 2 * hstep;
    const unsigned ldsw = (unsigned)wid * 1024u;
    const int aoff = lds_byte(wr * 64 + fr, fq * 8), boff = lds_byte(wc * 32 + fr, fq * 8);
#define PG8_SA(b, h) (((b) * 2 + (h)) * HTB)
#define PG8_SB(b, h) ((4 + (b) * 2 + (h)) * HTB)
#define PG8_STAGE(bufoff, gbase, voff) do { _Pragma("unroll") for (int _i = 0; _i < 2; ++_i) \
        __builtin_amdgcn_global_load_lds((const unsigned*)((const char*)(gbase) + (voff)[_i]), (PG8_LAS unsigned*)(lds + (bufoff) + ldsw + _i * 8192), 16, 0, 0); } while (0)
#define PG8_LDA(dst, b, h) do { _Pragma("unroll") for (int m = 0; m < 4; ++m) _Pragma("unroll") for (int k = 0; k < 2; ++k) dst[m][k] = *(const PG8_LAS bf16x8*)(lds + PG8_SA(b, h) + aoff + m * 2048 + k * 1024); } while (0)
#define PG8_LDB(dst, b, h) do { _Pragma("unroll") for (int n = 0; n < 2; ++n) _Pragma("unroll") for (int k = 0; k < 2; ++k) dst[n][k] = *(const PG8_LAS bf16x8*)(lds + PG8_SB(b, h) + boff + n * 2048 + k * 1024); } while (0)
#define PG8_MMA(ai, bj, At, Bt) do { __builtin_amdgcn_s_setprio(1); _Pragma("unroll") for (int m = 0; m < 4; ++m) _Pragma("unroll") for (int n = 0; n < 2; ++n) _Pragma("unroll") for (int k = 0; k < 2; ++k) \
        acc[ai][bj][m][n] = __builtin_amdgcn_mfma_f32_16x16x32_bf16(Bt[n][k], At[m][k], acc[ai][bj][m][n], 0, 0, 0); __builtin_amdgcn_s_setprio(0); } while (0)
#define PG8_WAIT_V(n) asm volatile("s_waitcnt vmcnt(" #n ")" ::: "memory")
#define PG8_WAIT_L(n) asm volatile("s_waitcnt lgkmcnt(" #n ")" ::: "memory")
#define PG8_BAR __builtin_amdgcn_s_barrier()
#define PG8_SCHED __builtin_amdgcn_sched_barrier(0)
    Unit cur, nxt; int ui = 0;
    if (!S.next(0, cur)) return;
    f32x4 acc[2][2][4][2];
#pragma unroll
    for (int a = 0; a < 2; ++a)
#pragma unroll
        for (int b = 0; b < 2; ++b)
#pragma unroll
            for (int m = 0; m < 4; ++m)
#pragma unroll
                for (int n = 0; n < 2; ++n) acc[a][b][m][n] = (f32x4){0.f, 0.f, 0.f, 0.f};
    bf16x8 At[4][2], B0[2][2], B1[2][2];
#define PG8_UA(u) ((const char*)((TwoSeg<Epi>::v && (u).seg == 0) ? g.A0 : g.A) + (size_t)(u).pm * tstep)
#define PG8_UB(u) ((const char*)((TwoSeg<Epi>::v && (u).seg == 0) ? g.Bt0 : g.Bt) + (size_t)(u).pn * tstep)
    const char* cA = PG8_UA(cur); const char* cB = PG8_UB(cur);
    S.a_ready(cur);
    if constexpr (SP2) {
        PG8_STAGE(PG8_SB(0, 0), cB, voffB); PG8_STAGE(PG8_SB(0, 1), cB + hstep, voffB); PG8_STAGE(PG8_SA(0, 0), cA, voffA); PG8_STAGE(PG8_SA(0, 1), cA + hstep, voffA);
        if (wr == 1) PG8_BAR;
        PG8_WAIT_V(2); PG8_BAR;
        PG8_STAGE(PG8_SB(1, 0), cB + kstep, voffB); PG8_STAGE(PG8_SA(1, 0), cA + kstep, voffA); PG8_STAGE(PG8_SB(1, 1), cB + hstep + kstep, voffB);
        PG8_WAIT_V(6); PG8_BAR;
    } else {
        PG8_STAGE(PG8_SB(0, 0), cB, voffB); PG8_STAGE(PG8_SA(0, 0), cA, voffA); PG8_STAGE(PG8_SB(0, 1), cB + hstep, voffB); PG8_STAGE(PG8_SA(0, 1), cA + hstep, voffA);
        if (wr == 1) PG8_BAR;
        PG8_WAIT_V(4); PG8_BAR;
        PG8_STAGE(PG8_SB(1, 0), cB + kstep, voffB); PG8_STAGE(PG8_SA(1, 0), cA + kstep, voffA); PG8_STAGE(PG8_SB(1, 1), cB + hstep + kstep, voffB);
        PG8_WAIT_V(6); PG8_BAR;
    }
    for (;;) {
        const bool has_next = S.next(ui + 1, nxt);
        const char* nA = has_next ? PG8_UA(nxt) : cA; const char* nB = has_next ? PG8_UB(nxt) : cB;
        const int nt = (TwoSeg<Epi>::v && cur.seg == 0) ? nt0 : nt1;
        for (int t = 0; t < nt; t += 2) {
            const bool last = (t == nt - 2);
            const char* a1 = cA + (size_t)(t + 1) * kstep;
            const char* a2 = last ? nA : cA + (size_t)(t + 2) * kstep; const char* b2 = last ? nB : cB + (size_t)(t + 2) * kstep;
            const char* a3 = a2 + kstep; const char* b3 = b2 + kstep;
            if (last && has_next) S.a_ready(nxt);
            if constexpr (SP2) {
            PG8_LDB(B0, 0, 0); PG8_LDB(B1, 0, 1); PG8_SCHED; PG8_LDA(At, 0, 0); PG8_STAGE(PG8_SA(1, 1), a1 + hstep, voffA);
            PG8_WAIT_V(8); PG8_WAIT_L(0); PG8_BAR; PG8_MMA(0, 0, At, B0); PG8_MMA(0, 1, At, B1); PG8_BAR; PG8_SCHED;
            PG8_LDA(At, 0, 1); PG8_STAGE(PG8_SB(0, 0), b2, voffB); PG8_STAGE(PG8_SB(0, 1), b2 + hstep, voffB); PG8_STAGE(PG8_SA(0, 0), a2, voffA);
            PG8_WAIT_V(8); PG8_WAIT_L(0); PG8_BAR; PG8_MMA(1, 0, At, B0); PG8_MMA(1, 1, At, B1); PG8_BAR; PG8_SCHED;
            PG8_LDB(B0, 1, 0); PG8_LDB(B1, 1, 1); PG8_SCHED; PG8_LDA(At, 1, 0); PG8_STAGE(PG8_SA(0, 1), a2 + hstep, voffA);
            PG8_WAIT_V(8); PG8_WAIT_L(0); PG8_BAR; PG8_MMA(0, 0, At, B0); PG8_MMA(0, 1, At, B1); PG8_BAR; PG8_SCHED;
            PG8_LDA(At, 1, 1); PG8_STAGE(PG8_SB(1, 0), b3, voffB); PG8_STAGE(PG8_SB(1, 1), b3 + hstep, voffB); PG8_STAGE(PG8_SA(1, 0), a3, voffA);
            PG8_WAIT_V(8); PG8_WAIT_L(0); PG8_BAR; PG8_MMA(1, 0, At, B0); PG8_MMA(1, 1, At, B1); PG8_BAR; PG8_SCHED;
            } else {
            PG8_LDB(B0, 0, 0); PG8_SCHED; PG8_LDA(At, 0, 0); PG8_STAGE(PG8_SA(1, 1), a1 + hstep, voffA);
            PG8_WAIT_L(8); PG8_BAR; PG8_WAIT_L(0); PG8_MMA(0, 0, At, B0); PG8_BAR; PG8_SCHED;
            PG8_LDB(B1, 0, 1); PG8_STAGE(PG8_SB(0, 0), b2, voffB);
            PG8_BAR; PG8_WAIT_L(0); PG8_MMA(0, 1, At, B1); PG8_BAR;
            PG8_LDA(At, 0, 1); PG8_STAGE(PG8_SA(0, 0), a2, voffA);
            PG8_BAR; PG8_WAIT_L(0); PG8_MMA(1, 0, At, B0); PG8_BAR; PG8_SCHED;
            PG8_STAGE(PG8_SB(0, 1), b2 + hstep, voffB);
            PG8_WAIT_V(6); PG8_BAR; PG8_MMA(1, 1, At, B1); PG8_BAR;
            PG8_LDB(B0, 1, 0); PG8_SCHED; PG8_LDA(At, 1, 0); PG8_STAGE(PG8_SA(0, 1), a2 + hstep, voffA);
            PG8_WAIT_L(8); PG8_BAR; PG8_WAIT_L(0); PG8_MMA(0, 0, At, B0); PG8_BAR; PG8_SCHED;
            PG8_LDB(B1, 1, 1); PG8_STAGE(PG8_SB(1, 0), b3, voffB);
            PG8_BAR; PG8_WAIT_L(0); PG8_MMA(0, 1, At, B1); PG8_BAR;
            PG8_LDA(At, 1, 1); PG8_STAGE(PG8_SA(1, 0), a3, voffA);
            PG8_BAR; PG8_WAIT_L(0); PG8_MMA(1, 0, At, B0); PG8_BAR; PG8_SCHED;
            PG8_STAGE(PG8_SB(1, 1), b3 + hstep, voffB);
            PG8_WAIT_V(6); PG8_BAR; PG8_MMA(1, 1, At, B1); PG8_BAR;
            }
        }
        if constexpr (ALIGN_EPI) { if (wr == 0) PG8_BAR; }
        if constexpr (!Epi::AFTER_DRAIN) { E(acc, cur, wr, wc, fr, fq); S.done(cur); }
        if (!has_next) break;
        if (!(TwoSeg<Epi>::v && cur.seg == 0)) {
#pragma unroll
        for (int a = 0; a < 2; ++a)
#pragma unroll
            for (int b = 0; b < 2; ++b)
#pragma unroll
                for (int m = 0; m < 4; ++m)
#pragma unroll
                    for (int n = 0; n < 2; ++n) acc[a][b][m][n] = (f32x4){0.f, 0.f, 0.f, 0.f};
        }
        cur = nxt; cA = nA; cB = nB; ++ui;
        if constexpr (ALIGN_EPI) { if (wr == 1) PG8_BAR; }
    }
    PG8_WAIT_V(0);
    if constexpr (!ALIGN_EPI) { if (wr == 0) PG8_BAR; }
    PG8_BAR;
    if constexpr (Epi::AFTER_DRAIN) { E.fused(acc, cur, wr, wc, fr, fq, lds, wid, lane); S.done(cur); }
#undef PG8_UA
#undef PG8_UB
#undef PG8_SA
#undef PG8_SB
#undef PG8_STAGE
#undef PG8_LDA
#undef PG8_LDB
#undef PG8_MMA
#undef PG8_WAIT_V
#undef PG8_WAIT_L
#undef PG8_BAR
#undef PG8_SCHED
}
}

#define ACC8(v, ai, bj, m) const float v[8] = {acc[ai][bj][m][0][0], acc[ai][bj][m][0][1], acc[ai][bj][m][0][2], acc[ai][bj][m][0][3], acc[ai][bj][m][1][0], acc[ai][bj][m][1][1], acc[ai][bj][m][1][2], acc[ai][bj][m][1][3]}
template <class E8> struct EpiWrap {
    static constexpr bool PERM = true, AFTER_DRAIN = false;
    E8 e;
    __device__ __forceinline__ void operator()(const pg8::f32x4 (&acc)[2][2][4][2], const pg8::Unit& u, int wr, int wc, int fr, int fq) const {
#pragma unroll
        for (int ai = 0; ai < 2; ++ai)
#pragma unroll
            for (int m = 0; m < 4; ++m)
#pragma unroll
                for (int bj = 0; bj < 2; ++bj) { ACC8(v, ai, bj, m); e(u.pm * 256 + ai * 128 + wr * 64 + m * 16 + fr, u.pn * 256 + bj * 128 + wc * 32 + 8 * fq, v); }
    }
};
struct SegOrder : pg8::StaticOrder {
    __device__ __forceinline__ bool next(int i, pg8::Unit& u) const { if (!pg8::StaticOrder::next(i >> 1, u)) return false; u.seg = i & 1; return true; }
};
struct EpiMerge {
    static constexpr bool PERM = true, AFTER_DRAIN = false;
    bf16_t* U; const bf16_t* GATES;
    __device__ __forceinline__ void operator()(pg8::f32x4 (&acc)[2][2][4][2], const pg8::Unit& u, int wr, int wc, int fr, int fq) const {
#pragma unroll
        for (int ai = 0; ai < 2; ++ai)
#pragma unroll
            for (int m = 0; m < 4; ++m)
#pragma unroll
                for (int bj = 0; bj < 2; ++bj) {
                    const int row = u.pm * 256 + ai * 128 + wr * 64 + m * 16 + fr, c0 = u.pn * 256 + bj * 128 + wc * 32 + 8 * fq;
                    if (u.seg == 0) { float rr[8]; unpack8(__builtin_nontemporal_load((const u32x4*)(GATES + (size_t)row * 2048 + 1024 + c0)), rr);
#pragma unroll
                        for (int i = 0; i < 8; ++i) acc[ai][bj][m][i >> 2][i & 3] *= rr[i];
                    } else { float ga[8], o[8]; unpack8(__builtin_nontemporal_load((const u32x4*)(GATES + (size_t)row * 2048 + c0)), ga);
#pragma unroll
                        for (int i = 0; i < 8; ++i) o[i] = ga[i] * acc[ai][bj][m][i >> 2][i & 3];
                        *(u32x4*)(U + (size_t)row * DM + c0) = pack8(o); }
                }
    }
};
namespace pg8 { template <> struct TwoSeg<EpiMerge> { static constexpr bool v = true; }; }
struct EpiOutF {
    static constexpr bool PERM = true, AFTER_DRAIN = false;
    EpiOut e; float* SSQ; LAS float* xb;
    __device__ __forceinline__ void operator()(const pg8::f32x4 (&acc)[2][2][4][2], const pg8::Unit& u, int wr, int wc, int fr, int fq) const {
        LAS char* xl = (LAS char*)xb + ((wr * 64 + fr) * 8 + wc) * 4; asm volatile("" : "+v"(xl));
        const int b = u.pm >> 4; const float* mb = e.mod + (size_t)b * NMOD;
#pragma unroll
        for (int bj = 0; bj < 2; ++bj) {
            const int c0 = u.pn * 256 + bj * 128 + wc * 32 + 8 * fq; float g1[8], gm[8];
#pragma unroll
            for (int h = 0; h < 2; ++h) { const f32x4 a = *(const f32x4*)(mb + 2 * DM + c0 + 4 * h), sc = *(const f32x4*)(mb + 4 * DM + c0 + 4 * h), ng = *(const f32x4*)(e.n2g + c0 + 4 * h);
#pragma unroll
                for (int i = 0; i < 4; ++i) { g1[4 * h + i] = a[i]; gm[4 * h + i] = ng[i] * (1.0f + sc[i]); } }
#pragma unroll
            for (int ai = 0; ai < 2; ++ai) {
                f32x4 xa[4], xc[4];
#pragma unroll
                for (int m = 0; m < 4; ++m) { const size_t off = (size_t)(u.pm * 256 + ai * 128 + wr * 64 + m * 16 + fr) * DM + c0; xa[m] = __builtin_nontemporal_load((const f32x4*)(e.x + off)); xc[m] = __builtin_nontemporal_load((const f32x4*)(e.x + off + 4)); }
#pragma unroll
                for (int m = 0; m < 4; ++m) { ACC8(v, ai, bj, m); const size_t off = (size_t)(u.pm * 256 + ai * 128 + wr * 64 + m * 16 + fr) * DM + c0;
                    float o[8], y[8], s = 0.f;
#pragma unroll
                    for (int i = 0; i < 8; ++i) { o[i] = (i < 4 ? xa[m][i & 3] : xc[m][i & 3]) + g1[i] * v[i]; s += o[i] * o[i]; y[i] = o[i] * gm[i]; }
                    *(f32x4*)(e.out + off) = (f32x4){o[0], o[1], o[2], o[3]}; *(f32x4*)(e.out + off + 4) = (f32x4){o[4], o[5], o[6], o[7]};
                    *(u32x4*)(e.Y2 + off) = pack8(y);
                    s += __shfl_xor(s, 16); s += __shfl_xor(s, 32);
                    if (fq == 0) *(LAS float*)(xl + ((ai * 128 + m * 16) * 8 + bj * 4) * 4) = s; }
                asm volatile("" ::: "memory");
            }
        }
        LDS_WAIT(); __builtin_amdgcn_s_barrier(); asm volatile("" ::: "memory");
        const int t = threadIdx.x;
        if (t < 256) { LAS char* xr = (LAS char*)xb + t * 32; asm volatile("" : "+v"(xr)); const f32x4 a = *(const LAS f32x4*)xr, b2 = *(const LAS f32x4*)(xr + 16);
            SSQ[(size_t)(u.pm * 256 + t) * 4 + u.pn] = ((a[0] + a[1]) + (a[2] + a[3])) + ((b2[0] + b2[1]) + (b2[2] + b2[3])); }
    }
};
struct EpiUpF {
    static constexpr bool PERM = true, AFTER_DRAIN = false;
    EpiUp e; const float* SSQ;
    __device__ __forceinline__ void operator()(const pg8::f32x4 (&acc)[2][2][4][2], const pg8::Unit& u, int wr, int wc, int fr, int fq) const {
        const int b = u.pm >> 4, c0 = u.pn * 128 + wc * 32 + 8 * fq; const float* bb = e.bias2 + (size_t)b * NUP + u.pn * 256 + wc * 32 + 8 * fq; float ba[8], bg[8];
#pragma unroll
        for (int h = 0; h < 2; ++h) { const f32x4 a = *(const f32x4*)(bb + 4 * h), g = *(const f32x4*)(bb + 128 + 4 * h);
#pragma unroll
            for (int i = 0; i < 4; ++i) { ba[4 * h + i] = a[i]; bg[4 * h + i] = g[i]; } }
#pragma unroll
        for (int ai = 0; ai < 2; ++ai)
#pragma unroll
            for (int m = 0; m < 4; ++m) { ACC8(va, ai, 0, m); ACC8(vb, ai, 1, m); const int row = u.pm * 256 + ai * 128 + wr * 64 + m * 16 + fr; const float rstd = row_rstd(SSQ, row); float o[8];
#pragma unroll
                for (int i = 0; i < 8; ++i) o[i] = siluf_(rstd * va[i] + ba[i]) * (rstd * vb[i] + bg[i]);
                *(u32x4*)(e.ACT + (size_t)row * FF + c0) = pack8(o); }
    }
};
struct EpiDownF {
    static constexpr bool PERM = true, AFTER_DRAIN = false;
    EpiDown e;
    __device__ __forceinline__ void operator()(const pg8::f32x4 (&acc)[2][2][4][2], const pg8::Unit& u, int wr, int wc, int fr, int fq) const {
        const int b = u.pm >> 4;
#pragma unroll
        for (int bj = 0; bj < 2; ++bj) { const int c0 = u.pn * 256 + bj * 128 + wc * 32 + 8 * fq; const float* g2p = e.mod + (size_t)b * NMOD + 5 * DM + c0; const f32x4 ga = *(const f32x4*)g2p, gb = *(const f32x4*)(g2p + 4);
#pragma unroll
            for (int ai = 0; ai < 2; ++ai)
#pragma unroll
                for (int m = 0; m < 4; ++m) { ACC8(v, ai, bj, m); const size_t off = (size_t)(u.pm * 256 + ai * 128 + wr * 64 + m * 16 + fr) * DM + c0;
                    f32x4 xa = __builtin_nontemporal_load((const f32x4*)(e.out + off)), xc = __builtin_nontemporal_load((const f32x4*)(e.out + off + 4));
#pragma unroll
                    for (int i = 0; i < 4; ++i) { xa[i] += ga[i] * v[i]; xc[i] += gb[i] * v[4 + i]; }
                    float* dst = e.dump ? e.dump + (off & (size_t)0x7ffff8) : e.out + off;
                    __builtin_nontemporal_store(xa, (f32x4*)dst); __builtin_nontemporal_store(xc, (f32x4*)(dst + 4)); }
        }
    }
};
template <bool CTXMODE> struct EpiInF {
    static constexpr bool PERM = true, AFTER_DRAIN = false;
    bf16_t *Q, *K, *Kc; const float *qg, *kg; EpiInRest rest; EpiCtxV cv; LAS float* xb;
    __device__ __forceinline__ void operator()(const pg8::f32x4 (&acc)[2][2][4][2], const pg8::Unit& u, int wr, int wc, int fr, int fq) const {
        const bool normed = CTXMODE ? (u.pn == 0) : (u.pn < 5);
        if (!normed) {
            if (CTXMODE) {
#pragma unroll
                for (int ai = 0; ai < 2; ++ai)
#pragma unroll
                    for (int m = 0; m < 4; ++m)
#pragma unroll
                        for (int bj = 0; bj < 2; ++bj) { ACC8(v, ai, bj, m); cv(u.pm * 256 + ai * 128 + wr * 64 + m * 16 + fr, bj * 128 + wc * 32 + 8 * fq, v); }
            } else if (u.pn < 8) {
#pragma unroll
                for (int ai = 0; ai < 2; ++ai)
#pragma unroll
                    for (int m = 0; m < 4; ++m)
#pragma unroll
                        for (int bj = 0; bj < 2; ++bj) { ACC8(v, ai, bj, m); rest(u.pm * 256 + ai * 128 + wr * 64 + m * 16 + fr, u.pn * 256 + bj * 128 + wc * 32 + 8 * fq, v); }
            } else {
                const int c0 = (u.pn - 8) * 128 + wc * 32 + 8 * fq; float ba[8], bp[8];
#pragma unroll
                for (int h = 0; h < 2; ++h) { const f32x4 a = *(const f32x4*)(rest.gate_b + c0 + 4 * h), p = *(const f32x4*)(rest.gate_b + 1024 + c0 + 4 * h);
#pragma unroll
                    for (int i = 0; i < 4; ++i) { ba[4 * h + i] = a[i]; bp[4 * h + i] = p[i]; } }
#pragma unroll
                for (int ai = 0; ai < 2; ++ai)
#pragma unroll
                    for (int m = 0; m < 4; ++m) { ACC8(va, ai, 0, m); ACC8(vp, ai, 1, m); float oa[8], orr[8];
#pragma unroll
                        for (int i = 0; i < 8; ++i) { const float ea = fminf(1.0f + __builtin_amdgcn_exp2f(-LOG2E * (va[i] + ba[i])), 1e30f), ep = 1.0f + __builtin_amdgcn_exp2f(-LOG2E * (vp[i] + bp[i]));
                            oa[i] = __builtin_amdgcn_rcpf(ea); orr[i] = ea * __builtin_amdgcn_rcpf(ep); }
                        bf16_t* gp_ = rest.GATES + (size_t)(u.pm * 256 + ai * 128 + wr * 64 + m * 16 + fr) * 2048 + c0;
                        *(u32x4*)gp_ = pack8(oa); *(u32x4*)(gp_ + 1024) = pack8(orr); }
            }
            return;
        }
        const bool isq = u.pn < 4; const float* g = isq ? qg : kg;
        float g1[2][4], g2[2][4];
#pragma unroll
        for (int bj = 0; bj < 2; ++bj) { const f32x4 a1 = *(const f32x4*)(g + 32 * bj + 4 * fq), a2 = *(const f32x4*)(g + 32 * bj + 16 + 4 * fq);
#pragma unroll
            for (int i = 0; i < 4; ++i) { g1[bj][i] = a1[i]; g2[bj][i] = a2[i]; } }
        const LAS float* tab = xb + 2048 + 4 * fq; asm volatile("" : "+v"(tab));
        bf16_t* dbase = isq ? Q + (size_t)(u.pn * 4 + wc) * 64 + 4 * fq : K + (size_t)wc * 64 + 4 * fq; const int dpitch = isq ? DM : KVW;
#pragma unroll
        for (int ai = 0; ai < 2; ++ai)
#pragma unroll
            for (int m = 0; m < 4; ++m) {
                const int row = u.pm * 256 + ai * 128 + wr * 64 + m * 16 + fr, t = row & 4095;
                float s = 0.f;
#pragma unroll
                for (int bj = 0; bj < 2; ++bj) { ACC8(v, ai, bj, m);
#pragma unroll
                    for (int i = 0; i < 8; ++i) s += v[i] * v[i]; }
                s += __shfl_xor(s, 16); s += __shfl_xor(s, 32);
                const float rstd = __builtin_amdgcn_rsqf(s * (1.0f / 64.0f) + EPS) * (isq ? QSCALE : 1.0f);
#pragma unroll
                for (int bj = 0; bj < 2; ++bj) { ACC8(v, ai, bj, m); const int pos = bj ? (t & 63) : (t >> 6);
                    const f32x4 cs = *(const LAS f32x4*)(tab + pos * 16), sn = *(const LAS f32x4*)(tab + 1024 + pos * 16); float o1[4], o2[4];
#pragma unroll
                    for (int i = 0; i < 4; ++i) { const float x1 = v[i] * rstd * g1[bj][i], x2 = v[4 + i] * rstd * g2[bj][i]; o1[i] = x1 * cs[i] - x2 * sn[i]; o2[i] = x2 * cs[i] + x1 * sn[i]; }
                    bf16_t* dst = dbase + (size_t)row * dpitch + 32 * bj; u32x2 w1, w2;
                    w1.x = cvtpk(o1[0], o1[1]); w1.y = cvtpk(o1[2], o1[3]); w2.x = cvtpk(o2[0], o2[1]); w2.y = cvtpk(o2[2], o2[3]);
                    *(u32x2*)dst = w1; *(u32x2*)(dst + 16) = w2; }
            }
    }
};

typedef short bf16x8_t __attribute__((ext_vector_type(8)));
typedef float f32x16 __attribute__((ext_vector_type(16)));
__device__ __forceinline__ int crow(int reg, int h) { return (reg & 3) + 8 * (reg >> 2) + 4 * h; }
#define MFMA32(a, b, c) __builtin_amdgcn_mfma_f32_32x32x16_bf16((a), (b), (c), 0, 0, 0)
constexpr int AT_KP = 144, AT_VP = 272, AT_KB = 128 * AT_KP, AT_VB = 64 * AT_VP;
constexpr int AT_BUF = AT_KB + AT_VB;
constexpr int AT_K0 = 0, AT_V0 = 2 * AT_KB;

__device__ __forceinline__ bool attn_unit(const Ptrs& P, LAS unsigned char* lds, int unit, int tid, int wave, int lane, bool pre, int nxt) {
    const int n = unit & 31, kh = (unit >> 5) & 3, b = unit >> 7;
    const int g = wave & 3, q0 = 64 * (wave >> 2), h = kh * 4 + g, r = lane & 31, hh = lane >> 5;
    unsigned char* ws = P.ws;
    bf16_t* Qb = (bf16_t*)(ws + WS_Q) + (size_t)(b * SEQ + n * 128 + q0) * DM + h * 64;
    const bf16_t* Kg = (const bf16_t*)(ws + WS_K) + (size_t)b * SEQ * KVW + kh * 64; const bf16_t* Vg = (const bf16_t*)(ws + WS_VT) + (size_t)(b * 4 + kh) * 64 * SEQ;
    const bf16_t* Kcg = (const bf16_t*)(ws + WS_KC) + (size_t)b * CTX * KVW + kh * 64; const bf16_t* Vcg = (const bf16_t*)(ws + WS_VCT) + (size_t)(b * 4 + kh) * 64 * CTX;
    float mq = fabsf(P.qg[lane]), mk = fabsf(P.kg[lane]);
#pragma unroll
    for (int o = 1; o < 64; o <<= 1) { mq = fmaxf(mq, __shfl_xor(mq, o)); mk = fmaxf(mk, __shfl_xor(mk, o)); }
    const float sink2 = P.sink[h] * LOG2E; const float mshift = fmaxf(64.0f * QSCALE * mq * mk, sink2);
    bf16x8_t qf[2][4];
#pragma unroll
    for (int cb = 0; cb < 2; ++cb)
#pragma unroll
        for (int ds = 0; ds < 4; ++ds) qf[cb][ds] = __builtin_nontemporal_load((const bf16x8_t*)(Qb + (size_t)(32 * cb + r) * DM + 16 * ds + 8 * hh));
    f32x16 o[2][2];
#pragma unroll
    for (int db = 0; db < 2; ++db)
#pragma unroll
        for (int cb = 0; cb < 2; ++cb)
#pragma unroll
            for (int i = 0; i < 16; ++i) o[db][cb][i] = 0.f;
    float rs[2] = {0.f, 0.f};
    f32x16 negm;
#pragma unroll
    for (int i = 0; i < 16; ++i) negm[i] = -mshift;
#define AT_DMA(c) do { const int b_ = (c) % 3; const bf16_t* kb_ = (c) < 3 ? Kg + (size_t)(n - 1 + (c)) * 128 * KVW : Kcg + (size_t)((c) - 3) * 128 * KVW; \
        const bf16_t* vb_ = (c) < 3 ? Vg + (n - 1 + (c)) * 128 : Vcg + ((c) - 3) * 128; const int vp_ = (c) < 3 ? SEQ : CTX; \
        for (int i_ = wave; i_ < 35; i_ += 8) { \
            if (i_ < 18) { const int q_ = 64 * i_ + lane, row_ = q_ / 9; int seg_ = q_ - 9 * row_; seg_ = seg_ == 8 ? 0 : seg_; \
                __builtin_amdgcn_global_load_lds((const unsigned*)(kb_ + (size_t)row_ * KVW + seg_ * 8), (LAS unsigned*)(lds + b_ * AT_BUF + i_ * 1024), 16, 0, 0); } \
            else { const int q_ = 64 * (i_ - 18) + lane, row_ = q_ / 17; int seg_ = q_ - 17 * row_; seg_ = seg_ == 16 ? 0 : seg_; \
                __builtin_amdgcn_global_load_lds((const unsigned*)(vb_ + (size_t)row_ * vp_ + seg_ * 8), (LAS unsigned*)(lds + b_ * AT_BUF + AT_KB + (i_ - 18) * 1024), 16, 0, 0); } } } while (0)
#define AT_SYNC() do { asm volatile("s_waitcnt vmcnt(0) lgkmcnt(0)" ::: "memory"); __builtin_amdgcn_s_barrier(); asm volatile("" ::: "memory"); } while (0)
    if (!pre) { if (n == 0) AT_DMA(1); else AT_DMA(0); }
    AT_SYNC();
    const int n2 = nxt & 31; const bool pf = nxt >= 0 && n2 != 0;
#pragma unroll
    for (int c = 0; c < 5; ++c) {
        if (c == 0 && n == 0) continue;
        if (c == 2 && n == 31) continue;
        if (c == 0) AT_DMA(1);
        if (c == 1) { if (n == 31) AT_DMA(3); else AT_DMA(2); }
        if (c == 2) AT_DMA(3);
        if (c == 3) AT_DMA(4);
        if (c == 4 && pf) { const int kh2 = (nxt >> 5) & 3, b2 = nxt >> 7; const bf16_t* kb_ = (const bf16_t*)(ws + WS_K) + (size_t)b2 * SEQ * KVW + kh2 * 64 + (size_t)(n2 - 1) * 128 * KVW; const bf16_t* vb_ = (const bf16_t*)(ws + WS_VT) + (size_t)(b2 * 4 + kh2) * 64 * SEQ + (n2 - 1) * 128;
            for (int i_ = wave; i_ < 35; i_ += 8) {
                if (i_ < 18) { const int q_ = 64 * i_ + lane, row_ = q_ / 9; int seg_ = q_ - 9 * row_; seg_ = seg_ == 8 ? 0 : seg_;
                    __builtin_amdgcn_global_load_lds((const unsigned*)(kb_ + (size_t)row_ * KVW + seg_ * 8), (LAS unsigned*)(lds + i_ * 1024), 16, 0, 0); }
                else { const int q_ = 64 * (i_ - 18) + lane, row_ = q_ / 17; int seg_ = q_ - 17 * row_; seg_ = seg_ == 16 ? 0 : seg_;
                    __builtin_amdgcn_global_load_lds((const unsigned*)(vb_ + (size_t)row_ * SEQ + seg_ * 8), (LAS unsigned*)(lds + AT_KB + (i_ - 18) * 1024), 16, 0, 0); } } }
        const LAS unsigned char* Kl = lds + (c % 3) * AT_BUF; const LAS unsigned char* Vl = Kl + AT_KB;
#pragma unroll 1
        for (int kt = 0; kt < 4; ++kt) {
            if (c == 0 && 32 * kt + 31 < q0) continue;
            if (c == 2 && 32 * kt > q0 + 63) continue;
            bf16x8_t kf[4], vf[2][2];
#pragma unroll
            for (int ds = 0; ds < 4; ++ds) kf[ds] = *(const LAS bf16x8_t*)(Kl + (32 * kt + r) * AT_KP + (16 * ds + 8 * hh) * 2);
#pragma unroll
            for (int db = 0; db < 2; ++db)
#pragma unroll
                for (int s = 0; s < 2; ++s) vf[db][s] = *(const LAS bf16x8_t*)(Vl + (32 * db + r) * AT_VP + (32 * kt + 16 * s + 8 * hh) * 2);
#pragma unroll
            for (int cb = 0; cb < 2; ++cb) {
                const int dq = 32 * kt - (q0 + 32 * cb);
                if ((c == 0 && dq < 0) || (c == 2 && dq > 0)) continue;
                const bool diag = (c == 0 || c == 2) && dq == 0;
                f32x16 st = MFMA32(kf[0], qf[cb][0], negm);
                st = MFMA32(kf[1], qf[cb][1], st); st = MFMA32(kf[2], qf[cb][2], st); st = MFMA32(kf[3], qf[cb][3], st);
                float p[16];
#pragma unroll
                for (int i = 0; i < 16; ++i) p[i] = __builtin_amdgcn_exp2f(st[i]);
                if (diag) {
                    const int thr = r - 4 * hh;
#pragma unroll
                    for (int i = 0; i < 16; ++i) { const bool vis = c == 0 ? crow(i, 0) >= thr : crow(i, 0) <= thr; p[i] = vis ? p[i] : 0.f; }
                }
                float s4 = 0.f;
#pragma unroll
                for (int i = 0; i < 16; ++i) s4 += p[i];
                rs[cb] += s4;
#pragma unroll
                for (int s = 0; s < 2; ++s) {
                    u32x4 w; w.x = cvtpk(p[8 * s], p[8 * s + 1]); w.y = cvtpk(p[8 * s + 2], p[8 * s + 3]); w.z = cvtpk(p[8 * s + 4], p[8 * s + 5]); w.w = cvtpk(p[8 * s + 6], p[8 * s + 7]);
                    const bf16x8_t pb = __builtin_bit_cast(bf16x8_t, w);
                    o[0][cb] = MFMA32(vf[0][s], pb, o[0][cb]); o[1][cb] = MFMA32(vf[1][s], pb, o[1][cb]);
                }
            }
        }
        AT_SYNC();
    }
#undef AT_DMA
#undef AT_SYNC
    const float sk = __builtin_amdgcn_exp2f(sink2 - mshift);
#pragma unroll
    for (int cb = 0; cb < 2; ++cb) {
        const float den = rs[cb] + __shfl_xor(rs[cb], 32) + sk; const float inv = __builtin_amdgcn_rcpf(den);
        bf16_t* orow = (bf16_t*)(ws + WS_ATT) + (size_t)(b * SEQ + n * 128 + q0 + 32 * cb + r) * DM + h * 64;
#pragma unroll
        for (int db = 0; db < 2; ++db)
#pragma unroll
            for (int p = 0; p < 2; ++p) { u32x2 w0, w1;
                w0.x = cvtpk(o[db][cb][8 * p] * inv, o[db][cb][8 * p + 1] * inv); w0.y = cvtpk(o[db][cb][8 * p + 2] * inv, o[db][cb][8 * p + 3] * inv);
                w1.x = cvtpk(o[db][cb][8 * p + 4] * inv, o[db][cb][8 * p + 5] * inv); w1.y = cvtpk(o[db][cb][8 * p + 6] * inv, o[db][cb][8 * p + 7] * inv);
                const auto sx = __builtin_amdgcn_permlane32_swap(w0.x, w1.x, false, false), sy = __builtin_amdgcn_permlane32_swap(w0.y, w1.y, false, false);
                u32x4 w; w.x = sx[0]; w.y = sy[0]; w.z = sx[1]; w.w = sy[1];
                *(u32x4*)(orow + 32 * db + 8 * (2 * p + hh)) = w; }
    }
    return pf;
}

constexpr int PL_U = 0, PL_A = 144 * 256, PL_AP = 272;
__device__ __forceinline__ void pool_unit(const Ptrs& P, LAS unsigned char* lds, int unit, int tid, int wave, int lane) {
    const int g = unit & 3, tt = unit >> 2, ts0 = (tt & 31) * 128; unsigned char* ws = P.ws;
    const bf16_t* PI = (const bf16_t*)(ws + WS_POOLIN) + (size_t)tt * 128 * POOLW + g * 128;
    for (int p = tid; p < 144 * 16; p += NTHR) { const int rr = p >> 4, seg = p & 15, ts = ts0 - 8 + rr; u32x4 v = {0u, 0u, 0u, 0u};
        if (ts >= 0 && ts < SEQ) v = __builtin_nontemporal_load((const u32x4*)(PI + (ptrdiff_t)(rr - 8) * POOLW + seg * 8));
        *(LAS u32x4*)(lds + PL_U + rr * 256 + seg * 16) = v; }
    LDS_WAIT(); __builtin_amdgcn_s_barrier(); asm volatile("" ::: "memory");
    {
        const int c = tid & 127, tl0 = (tid >> 7) * 32, w2 = 1 << g; const LAS bf16_t* U = (const LAS bf16_t*)(lds + PL_U) + c; float sum = 0.f;
        for (int j = tl0 - w2; j < tl0 + w2; ++j) sum += bf2f(U[(j + 8) * 128]);
        for (int tl = tl0; tl < tl0 + 32; ++tl) {
            const int ts = ts0 + tl, lo = ts - w2 < 0 ? 0 : ts - w2, hi = ts + w2 > SEQ ? SEQ : ts + w2;
            const float d = sum * __builtin_amdgcn_rcpf((float)(hi - lo)) - bf2f(U[(tl + 8) * 128]);
            *(LAS bf16_t*)(lds + PL_A + tl * PL_AP + c * 2) = (bf16_t)(cvtpk(d, 0.f) & 0xffffu);
            sum += bf2f(U[(tl + w2 + 8) * 128]) - bf2f(U[(tl - w2 + 8) * 128]);
        }
    }
    LDS_WAIT(); __builtin_amdgcn_s_barrier(); asm volatile("" ::: "memory");
    {
        const int rb = wave >> 1, r = lane & 31, hh = lane >> 5; const bf16_t* PWg = (const bf16_t*)(ws + WS_PW) + g * 16384;
        f32x16 acc[2];
#pragma unroll
        for (int j = 0; j < 2; ++j)
#pragma unroll
            for (int i = 0; i < 16; ++i) acc[j][i] = 0.f;
        bf16x8_t wa[2][8];
#pragma unroll
        for (int j = 0; j < 2; ++j)
#pragma unroll
            for (int ks = 0; ks < 8; ++ks) wa[j][ks] = *(const bf16x8_t*)(PWg + (size_t)(32 * (2 * (wave & 1) + j) + r) * 128 + 16 * ks + 8 * hh);
#pragma unroll
        for (int ks = 0; ks < 8; ++ks) {
            const bf16x8_t bt = *(const LAS bf16x8_t*)(lds + PL_A + (32 * rb + r) * PL_AP + (16 * ks + 8 * hh) * 2);
#pragma unroll
            for (int j = 0; j < 2; ++j) acc[j] = MFMA32(wa[j][ks], bt, acc[j]);
        }
        bf16_t* PMr = (bf16_t*)(ws + WS_PM) + (size_t)(tt * 128 + 32 * rb + r) * PMP + g * 128;
#pragma unroll
        for (int j = 0; j < 2; ++j)
#pragma unroll
            for (int g4 = 0; g4 < 4; ++g4) { const int d = 32 * (2 * (wave & 1) + j) + 8 * g4 + 4 * hh; const f32x4 sc = *(const f32x4*)(P.pool_scale + g * 128 + d);
                u32x2 w; w.x = cvtpk(acc[j][4 * g4] * sc[0], acc[j][4 * g4 + 1] * sc[1]); w.y = cvtpk(acc[j][4 * g4 + 2] * sc[2], acc[j][4 * g4 + 3] * sc[3]);
                *(u32x2*)(PMr + d) = w; }
    }
    LDS_WAIT(); __builtin_amdgcn_s_barrier(); asm volatile("" ::: "memory");
}

__device__ __forceinline__ void pool_units(const Ptrs& P, LAS unsigned char* lds, int bx, int G, int tid, int wave, int lane) {
    unsigned char* ws = P.ws; const int NU = (MTOK / 128) * 4;
    int u = bx; if (u >= NU) return;
    u32x4 tv[5]; bf16x8_t wa[2][8]; int gcur = -1;
    const int r = lane & 31, hh = lane >> 5, rb = wave >> 1;
#define PL_LOAD(unit_) do { const int g_ = (unit_) & 3, tt_ = (unit_) >> 2, ts0_ = (tt_ & 31) * 128; const bf16_t* PI_ = (const bf16_t*)(ws + WS_POOLIN) + (size_t)tt_ * 128 * POOLW + g_ * 128; \
        _Pragma("unroll") for (int i_ = 0; i_ < 5; ++i_) { const int p_ = tid + NTHR * i_, rr_ = p_ >> 4, seg_ = p_ & 15, ts_ = ts0_ - 8 + rr_; tv[i_] = (u32x4){0u, 0u, 0u, 0u}; \
            if (p_ < 144 * 16 && ts_ >= 0 && ts_ < SEQ) tv[i_] = __builtin_nontemporal_load((const u32x4*)(PI_ + (ptrdiff_t)(rr_ - 8) * POOLW + seg_ * 8)); } } while (0)
    PL_LOAD(u);
    for (;;) {
        const int g = u & 3, tt = u >> 2, ts0 = (tt & 31) * 128;
#pragma unroll
        for (int i = 0; i < 5; ++i) { const int p = tid + NTHR * i; if (p < 144 * 16) *(LAS u32x4*)(lds + PL_U + (p >> 4) * 256 + (p & 15) * 16) = tv[i]; }
        if (g != gcur) { const bf16_t* PWg = (const bf16_t*)(ws + WS_PW) + g * 16384; gcur = g;
#pragma unroll
            for (int j = 0; j < 2; ++j)
#pragma unroll
                for (int ks = 0; ks < 8; ++ks) wa[j][ks] = *(const bf16x8_t*)(PWg + (size_t)(32 * (2 * (wave & 1) + j) + r) * 128 + 16 * ks + 8 * hh); }
        LDS_WAIT(); __builtin_amdgcn_s_barrier(); asm volatile("" ::: "memory");
        const int un = u + G; const bool hasn = un < NU;
        if (hasn) PL_LOAD(un);
        {
            const int c = tid & 127, tl0 = (tid >> 7) * 32, w2 = 1 << g; const LAS bf16_t* U = (const LAS bf16_t*)(lds + PL_U) + c; float sum = 0.f;
            for (int j = tl0 - w2; j < tl0 + w2; ++j) sum += bf2f(U[(j + 8) * 128]);
            for (int tl = tl0; tl < tl0 + 32; ++tl) {
                const int ts = ts0 + tl, lo = ts - w2 < 0 ? 0 : ts - w2, hi = ts + w2 > SEQ ? SEQ : ts + w2;
                const float d = sum * __builtin_amdgcn_rcpf((float)(hi - lo)) - bf2f(U[(tl + 8) * 128]);
                *(LAS bf16_t*)(lds + PL_A + tl * PL_AP + c * 2) = (bf16_t)(cvtpk(d, 0.f) & 0xffffu);
                sum += bf2f(U[(tl + w2 + 8) * 128]) - bf2f(U[(tl - w2 + 8) * 128]);
            }
        }
        LDS_WAIT(); __builtin_amdgcn_s_barrier(); asm volatile("" ::: "memory");
        {
            f32x16 acc[2];
#pragma unroll
            for (int j = 0; j < 2; ++j)
#pragma unroll
                for (int i = 0; i < 16; ++i) acc[j][i] = 0.f;
#pragma unroll
            for (int ks = 0; ks < 8; ++ks) {
                const bf16x8_t bt = *(const LAS bf16x8_t*)(lds + PL_A + (32 * rb + r) * PL_AP + (16 * ks + 8 * hh) * 2);
#pragma unroll
                for (int j = 0; j < 2; ++j) acc[j] = MFMA32(wa[j][ks], bt, acc[j]);
            }
            bf16_t* PMr = (bf16_t*)(ws + WS_PM) + (size_t)(tt * 128 + 32 * rb + r) * PMP + g * 128;
#pragma unroll
            for (int j = 0; j < 2; ++j)
#pragma unroll
                for (int p = 0; p < 2; ++p) { const int d0 = 32 * (2 * (wave & 1) + j) + 16 * p + 4 * hh; const f32x4 s0 = *(const f32x4*)(P.pool_scale + g * 128 + d0), s1 = *(const f32x4*)(P.pool_scale + g * 128 + d0 + 8);
                    u32x2 w0, w1;
                    w0.x = cvtpk(acc[j][8 * p] * s0[0], acc[j][8 * p + 1] * s0[1]); w0.y = cvtpk(acc[j][8 * p + 2] * s0[2], acc[j][8 * p + 3] * s0[3]);
                    w1.x = cvtpk(acc[j][8 * p + 4] * s1[0], acc[j][8 * p + 5] * s1[1]); w1.y = cvtpk(acc[j][8 * p + 6] * s1[2], acc[j][8 * p + 7] * s1[3]);
                    const auto sx = __builtin_amdgcn_permlane32_swap(w0.x, w1.x, false, false), sy = __builtin_amdgcn_permlane32_swap(w0.y, w1.y, false, false);
                    u32x4 w; w.x = sx[0]; w.y = sy[0]; w.z = sx[1]; w.w = sy[1];
                    *(u32x4*)(PMr + 32 * (2 * (wave & 1) + j) + 8 * (2 * p + hh)) = w; }
        }
        LDS_WAIT(); __builtin_amdgcn_s_barrier(); asm volatile("" ::: "memory");
        if (!hasn) break;
        u = un;
    }
#undef PL_LOAD
}

typedef __attribute__((address_space(1))) unsigned gu32;
#define XB_TMO      128
#define XB_XCNT(j)  (256  + 64 * (j))
#define XB_XSUB(j)  (1280 + 64 * (j))
#define XB_XGEN(j)  (2304 + 64 * (j))
#define XB_TOP      3328
#define XB_TOPGEN   3392
#define XCD_BAR_WORDS 3456
#define XB_SPIN_CAP (1u << 18)

__device__ __forceinline__ unsigned xb_ld(unsigned* p)              { return __hip_atomic_load(p, __ATOMIC_RELAXED, __HIP_MEMORY_SCOPE_AGENT); }
__device__ __forceinline__ unsigned xb_add(unsigned* p, unsigned v) { return __hip_atomic_fetch_add(p, v, __ATOMIC_RELAXED, __HIP_MEMORY_SCOPE_AGENT); }
__device__ __forceinline__ unsigned xb_xcc_id() { return (unsigned)__builtin_amdgcn_s_getreg((3 << 11) | 20) & 0xFu; }
#define XB_SPIN(cond, bar) do { unsigned _sp = 0; while (cond) { __builtin_amdgcn_s_sleep(1); \
    if ((++_sp & 255u) == 0u) { if (xb_ld(&(bar)[XB_TMO])) break; if (_sp > XB_SPIN_CAP) { atomicAdd(&(bar)[XB_TMO], 1u); break; } } } } while (0)

struct XcdBarrier {
    unsigned* bar; unsigned x;
    volatile LAS unsigned* st;
};

__device__ __forceinline__ XcdBarrier xcd_barrier_post(unsigned* bar, volatile LAS unsigned* st) {
    XcdBarrier b; b.bar = bar; b.x = xb_xcc_id(); b.st = st;
    if (threadIdx.x == 0) (void)xb_add(&bar[XB_XCNT(b.x)], 1u);
    return b;
}
__device__ __forceinline__ void xcd_barrier_complete(unsigned* bar, unsigned x, unsigned& nloc, unsigned& nx) {
    const unsigned G = gridDim.x * gridDim.y * gridDim.z;
    unsigned sum, cnt, mine, sp = 0u;
    for (;;) {
        sum = 0u; cnt = 0u; mine = 0u;
#pragma unroll
        for (unsigned j = 0; j < 16; ++j) { const unsigned c = xb_ld(&bar[XB_XCNT(j)]); sum += c; cnt += (c > 0u) ? 1u : 0u; mine = (j == x) ? c : mine; }
        if (sum == G) break;
        __builtin_amdgcn_s_sleep(1);
        if ((++sp & 255u) == 0u) { if (xb_ld(&bar[XB_TMO])) break; if (sp > XB_SPIN_CAP) { atomicAdd(&bar[XB_TMO], 1u); break; } }
    }
    nloc = mine > 0u ? mine : 1u; nx = cnt > 0u ? cnt : 1u;
}

__device__ __forceinline__ void xcd_barrier(const XcdBarrier& b) {
    asm volatile("s_waitcnt vmcnt(0)" ::: "memory");
    __syncthreads();
    if (threadIdx.x == 0) {
        unsigned* bar = b.bar;
        __builtin_amdgcn_s_waitcnt(0);
        unsigned nloc = b.st[0], nx = b.st[1];
        if (nloc == 0u) { xcd_barrier_complete(bar, b.x, nloc, nx); b.st[0] = nloc; b.st[1] = nx; }
        const unsigned old = xb_add(&bar[XB_XSUB(b.x)], 1u);
        const unsigned gen = old / nloc;
        if (old + 1u == (gen + 1u) * nloc) {
            __builtin_amdgcn_fence(__ATOMIC_RELEASE, "agent");
            asm volatile("s_waitcnt vmcnt(0)" ::: "memory");
            const unsigned og = xb_add(&bar[XB_TOP], 1u);
            const unsigned tg = og / nx;
            if (og + 1u == (tg + 1u) * nx) xb_add(&bar[XB_TOPGEN], 1u);
            else XB_SPIN(xb_ld(&bar[XB_TOPGEN]) == tg, bar);
            __builtin_amdgcn_fence(__ATOMIC_ACQUIRE, "agent");
            xb_add(&bar[XB_XGEN(b.x)], 1u);
            asm volatile("s_waitcnt vmcnt(0)" ::: "memory");
        } else {
            XB_SPIN(xb_ld(&bar[XB_XGEN(b.x)]) == gen, bar);
            __builtin_amdgcn_fence(__ATOMIC_ACQUIRE, "agent");
            asm volatile("s_waitcnt vmcnt(0)" ::: "memory");
        }
    }
    __syncthreads();
}


__device__ __forceinline__ void ctx_tile(const Ptrs& P, LAS unsigned char* lds, int tile, int tid, int wave, int lane) {
    unsigned char* ws = P.ws; const int trow = tile >> 3, tcol = tile & 7, r = lane & 31, hh = lane >> 5;
    const bf16_t* A = (const bf16_t*)(ws + WS_H) + (size_t)(MTOK + 32 * trow + r) * DM + 128 * wave + 8 * hh;
    const bf16_t* Bw = (const bf16_t*)(ws + WS_WIN) + (size_t)(tcol < 4 ? 1024 + 32 * tcol + r : 1024 + 64 * tcol + r) * DM + 128 * wave + 8 * hh; const int bstep = tcol < 4 ? 128 : 32;
    f32x16 acc[2];
#pragma unroll
    for (int j = 0; j < 2; ++j)
#pragma unroll
        for (int i = 0; i < 16; ++i) acc[j][i] = 0.f;
#pragma unroll
    for (int ks = 0; ks < 8; ++ks) { const bf16x8_t a = *(const bf16x8_t*)(A + 16 * ks);
#pragma unroll
        for (int j = 0; j < 2; ++j) { const bf16x8_t b = *(const bf16x8_t*)(Bw + (size_t)bstep * j * DM + 16 * ks); acc[j] = MFMA32(a, b, acc[j]); } }
    LAS float* red = (LAS float*)lds;
#pragma unroll
    for (int j = 0; j < 2; ++j)
#pragma unroll
        for (int i = 0; i < 16; ++i) red[(wave * 32 + j * 16 + i) * 64 + lane] = acc[j][i];
    LDS_WAIT(); __builtin_amdgcn_s_barrier(); asm volatile("" ::: "memory");
    {
        const int row = tid >> 4, c = (tid & 15) * 4, cb = c >> 5, i = (row & 3) + 4 * (row >> 3), ln = (c & 31) + 32 * ((row >> 2) & 1);
        f32x4 s = {0.f, 0.f, 0.f, 0.f};
#pragma unroll
        for (int w = 0; w < 8; ++w) s += *(const LAS f32x4*)(red + (w * 32 + cb * 16 + i) * 64 + ln);
        const int crow_ = 32 * trow + row, b = crow_ >> 8, t = crow_ & 255;
        if (tcol < 4) {
            float q = (s[0] * s[0] + s[1] * s[1]) + (s[2] * s[2] + s[3] * s[3]);
            q += __shfl_xor(q, 1); q += __shfl_xor(q, 2); q += __shfl_xor(q, 4); q += __shfl_xor(q, 8);
            const int pj = c & 31, dk = 32 * cb + 16 * ((pj >> 2) & 1) + 4 * (pj >> 3);
            const float rstd = __builtin_amdgcn_rsqf(q * (1.0f / 64.0f) + EPS); const f32x4 g = *(const f32x4*)(P.kg + dk);
            u32x2 w; w.x = cvtpk(s[0] * rstd * g[0], s[1] * rstd * g[1]); w.y = cvtpk(s[2] * rstd * g[2], s[3] * rstd * g[3]);
            *(u32x2*)((bf16_t*)(ws + WS_KC) + (size_t)crow_ * KVW + tcol * 64 + dk) = w;
        } else {
            bf16_t* p = (bf16_t*)(ws + WS_VCT) + ((size_t)((b * 4 + (tcol - 4)) * 64 + c)) * CTX + perm16(t);
#pragma unroll
            for (int k = 0; k < 4; ++k) p[(size_t)k * CTX] = (bf16_t)(cvtpk(s[k], 0.f) & 0xffffu);
        }
    }
    LDS_WAIT(); __builtin_amdgcn_s_barrier(); asm volatile("" ::: "memory");
}
__device__ __forceinline__ void mk_p2(const Ptrs& P, LAS unsigned char* lds, int tid, int wave, int lane, int bx, int G, bool dry) {
    unsigned char* ws = P.ws; (void)tid; (void)wave; (void)lane;
    bf16_t *WIN = (bf16_t*)(ws + WS_WIN), *H = (bf16_t*)(ws + WS_H), *Q = (bf16_t*)(ws + WS_Q), *GATES = (bf16_t*)(ws + WS_GATES), *PG = (bf16_t*)(ws + WS_PG);
    const float* MOD = (const float*)(ws + WS_MOD); float* SSQ = (float*)(ws + WS_SSQ); (void)WIN; (void)H; (void)Q; (void)GATES; (void)PG; (void)MOD; (void)SSQ;
        EpiInRest rest{(bf16_t*)(ws + WS_VT), (bf16_t*)(ws + WS_POOLIN), GATES, P.gate_b}; EpiCtxV cv{(bf16_t*)(ws + WS_VCT)};
        for (int t = bx; t < 256; t += G) ctx_tile(P, lds, t, tid, wave, lane);
        { pg8::Gemm g{H, WIN, MTOK, INW, DM}; pg8::StaticOrder S; S.init(MTOK, INW, G, bx);
          EpiInF<false> E{Q, (bf16_t*)(ws + WS_K), (bf16_t*)(ws + WS_KC), P.qg, P.kg, rest, cv, (LAS float*)(lds + RING_BYTES)};
          pg8::gemm_phase<EpiInF<false>, pg8::StaticOrder, true, true>(lds, g, S, E); }
}
__device__ __forceinline__ void mk_p3(const Ptrs& P, LAS unsigned char* lds, int tid, int wave, int lane, int bx, int G, bool dry) {
    unsigned char* ws = P.ws; (void)tid; (void)wave; (void)lane;
    bf16_t *WIN = (bf16_t*)(ws + WS_WIN), *H = (bf16_t*)(ws + WS_H), *Q = (bf16_t*)(ws + WS_Q), *GATES = (bf16_t*)(ws + WS_GATES), *PG = (bf16_t*)(ws + WS_PG);
    const float* MOD = (const float*)(ws + WS_MOD); float* SSQ = (float*)(ws + WS_SSQ); (void)WIN; (void)H; (void)Q; (void)GATES; (void)PG; (void)MOD; (void)SSQ;
        { bool pre = false; for (int u = bx; u < NB * 32 * 4; u += G) pre = attn_unit(P, lds, u, tid, wave, lane, pre, u + G < NB * 32 * 4 ? u + G : -1); }
        pool_units(P, lds, bx, G, tid, wave, lane);
#if MK_DBL == 8
        for (int u = bx; u < (MTOK / 128) * 4; u += G) pool_unit(P, lds, u, tid, wave, lane);
#endif
}
__device__ __forceinline__ void mk_p4(const Ptrs& P, LAS unsigned char* lds, int tid, int wave, int lane, int bx, int G, bool dry) {
    unsigned char* ws = P.ws; (void)tid; (void)wave; (void)lane;
    bf16_t *WIN = (bf16_t*)(ws + WS_WIN), *H = (bf16_t*)(ws + WS_H), *Q = (bf16_t*)(ws + WS_Q), *GATES = (bf16_t*)(ws + WS_GATES), *PG = (bf16_t*)(ws + WS_PG);
    const float* MOD = (const float*)(ws + WS_MOD); float* SSQ = (float*)(ws + WS_SSQ); (void)WIN; (void)H; (void)Q; (void)GATES; (void)PG; (void)MOD; (void)SSQ;
        { pg8::Gemm g{(bf16_t*)(ws + WS_ATT), (bf16_t*)(ws + WS_WAP), MTOK, DM, DM, (bf16_t*)(ws + WS_PM), (bf16_t*)(ws + WS_WPP), POOLW}; SegOrder S; S.init(MTOK, DM, G, bx);
          EpiMerge E{PG, GATES}; pg8::gemm_phase<EpiMerge, SegOrder, true, true>(lds, g, S, E); }
}
__device__ __forceinline__ void mk_p5(const Ptrs& P, LAS unsigned char* lds, int tid, int wave, int lane, int bx, int G, bool dry) {
    unsigned char* ws = P.ws; (void)tid; (void)wave; (void)lane;
    bf16_t *WIN = (bf16_t*)(ws + WS_WIN), *H = (bf16_t*)(ws + WS_H), *Q = (bf16_t*)(ws + WS_Q), *GATES = (bf16_t*)(ws + WS_GATES), *PG = (bf16_t*)(ws + WS_PG);
    const float* MOD = (const float*)(ws + WS_MOD); float* SSQ = (float*)(ws + WS_SSQ); (void)WIN; (void)H; (void)Q; (void)GATES; (void)PG; (void)MOD; (void)SSQ;
        pg8::Gemm g{PG, (bf16_t*)(ws + WS_WOUT), MTOK, DM, DM}; pg8::StaticOrder S; S.init(MTOK, DM, G, bx);
        EpiOutF E{EpiOut{P.x, P.out, (bf16_t*)(ws + WS_Y2), MOD, P.n2g}, SSQ, (LAS float*)(lds + RING_BYTES)}; pg8::gemm_phase<EpiOutF, pg8::StaticOrder, true, true>(lds, g, S, E);
}
__device__ __forceinline__ void mk_p6(const Ptrs& P, LAS unsigned char* lds, int tid, int wave, int lane, int bx, int G, bool dry) {
    unsigned char* ws = P.ws; (void)tid; (void)wave; (void)lane;
    bf16_t *WIN = (bf16_t*)(ws + WS_WIN), *H = (bf16_t*)(ws + WS_H), *Q = (bf16_t*)(ws + WS_Q), *GATES = (bf16_t*)(ws + WS_GATES), *PG = (bf16_t*)(ws + WS_PG);
    const float* MOD = (const float*)(ws + WS_MOD); float* SSQ = (float*)(ws + WS_SSQ); (void)WIN; (void)H; (void)Q; (void)GATES; (void)PG; (void)MOD; (void)SSQ;
        pg8::Gemm g{(bf16_t*)(ws + WS_Y2), (bf16_t*)(ws + WS_WUP), MTOK, NUP, DM}; pg8::StaticOrder S; S.init(MTOK, NUP, G, bx);
        EpiUpF E{EpiUp{(bf16_t*)(ws + WS_ACT), (const float*)(ws + WS_B2)}, SSQ}; pg8::gemm_phase<EpiUpF, pg8::StaticOrder, true, true>(lds, g, S, E);
}
__device__ __forceinline__ void mk_p7(const Ptrs& P, LAS unsigned char* lds, int tid, int wave, int lane, int bx, int G, bool dry) {
    unsigned char* ws = P.ws; (void)tid; (void)wave; (void)lane;
    bf16_t *WIN = (bf16_t*)(ws + WS_WIN), *H = (bf16_t*)(ws + WS_H), *Q = (bf16_t*)(ws + WS_Q), *GATES = (bf16_t*)(ws + WS_GATES), *PG = (bf16_t*)(ws + WS_PG);
    const float* MOD = (const float*)(ws + WS_MOD); float* SSQ = (float*)(ws + WS_SSQ); (void)WIN; (void)H; (void)Q; (void)GATES; (void)PG; (void)MOD; (void)SSQ;
        pg8::Gemm g{(bf16_t*)(ws + WS_ACT), (bf16_t*)(ws + WS_WDN), MTOK, DM, FF}; pg8::StaticOrder S; S.init(MTOK, DM, G, bx);
        EpiDownF E{EpiDown{P.out, MOD, dry ? (float*)(ws + WS_Y2) : nullptr}}; pg8::gemm_phase<EpiDownF, pg8::StaticOrder, true, true>(lds, g, S, E);
}

#ifndef MK_MASK
#define MK_MASK_ 0xff
#else
#define MK_MASK_ MK_MASK
#endif
__global__ void __launch_bounds__(NTHR, 2) mk_fwd(MkArgs a) {
    extern __shared__ __attribute__((aligned(16))) unsigned char lds_raw[];
    LAS unsigned char* lds = (LAS unsigned char*)lds_raw;
    cg::grid_group grid = cg::this_grid();
    const Ptrs& P = a.P;
    const int tid = threadIdx.x, lane = tid & 63, wave = __builtin_amdgcn_readfirstlane(tid >> 6), bx = blockIdx.x, G = gridDim.x;
    const int lo = a.ph_lo, hi = a.ph_hi;
#ifndef MK_MASK
#define MK_MASK 0xff
#endif
#define IN(k) (((MK_MASK >> (k)) & 1) && lo <= (k) && (k) < hi)
    volatile LAS unsigned* bst = (volatile LAS unsigned*)(lds + 147456);
    if (tid < 2) bst[tid] = 0u;
    if (((MK_MASK_ >> 2) & 1) && a.ph_lo <= 2 && 2 < a.ph_hi) {
        for (int i = tid; i < 1024; i += NTHR) { const int pos = i >> 4, f = i & 15; const float ang = (float)pos * exp2f(-(float)f * (13.287712379549449f / 16.0f));
            ((LAS float*)(lds + RING_BYTES))[2048 + i] = cosf(ang); ((LAS float*)(lds + RING_BYTES))[3072 + i] = sinf(ang); }
    }
    __syncthreads();
    const XcdBarrier xbar = xcd_barrier_post((unsigned*)P.ws, bst);
    if (lo < 0) grid.sync();
#define GRID_SYNC() xcd_barrier(xbar)
#define SEAM(k) do { if (IN(k) && IN((k) + 1)) GRID_SYNC(); } while (0)
    for (int i = 0; i < MK_SYNCX; ++i) GRID_SYNC();
    if (IN(0)) { mk_p0(P, lds, tid, wave, lane, bx, G);
#if MK_DBL == 0
        GRID_SYNC(); mk_p0(P, lds, tid, wave, lane, bx, G);
#endif
    }
    SEAM(0);
    if (IN(1)) { mk_p1(P, wave, lane, bx, G);
#if MK_DBL == 1
        GRID_SYNC(); mk_p1(P, wave, lane, bx, G);
#endif
    }
    SEAM(1);
    if (IN(2)) { mk_p2(P, lds, tid, wave, lane, bx, G, false);
#if MK_DBL == 2
        GRID_SYNC(); mk_p2(P, lds, tid, wave, lane, bx, G, true);
#endif
    }
    SEAM(2);
    if (IN(3)) { mk_p3(P, lds, tid, wave, lane, bx, G, false);
#if MK_DBL == 3
        GRID_SYNC(); mk_p3(P, lds, tid, wave, lane, bx, G, true);
#endif
    }
    SEAM(3);
    if (IN(4)) { mk_p4(P, lds, tid, wave, lane, bx, G, false);
#if MK_DBL == 4
        GRID_SYNC(); mk_p4(P, lds, tid, wave, lane, bx, G, true);
#endif
    }
    SEAM(4);
    if (IN(5)) { mk_p5(P, lds, tid, wave, lane, bx, G, false);
#if MK_DBL == 5
        GRID_SYNC(); mk_p5(P, lds, tid, wave, lane, bx, G, true);
#endif
    }
    SEAM(5);
    if (IN(6)) { mk_p6(P, lds, tid, wave, lane, bx, G, false);
#if MK_DBL == 6
        GRID_SYNC(); mk_p6(P, lds, tid, wave, lane, bx, G, true);
#endif
    }
    SEAM(6);
    if (IN(7)) { mk_p7(P, lds, tid, wave, lane, bx, G, false);
#if MK_DBL == 7
        GRID_SYNC(); mk_p7(P, lds, tid, wave, lane, bx, G, true);
#endif
    }
    SEAM(7);
#undef IN
#undef SEAM
}

static int mk_grid() {
    static int grid = 0;
    if (grid == 0) {
        int dev = 0, cus = 0, per_cu = 0;
        if (hipGetDevice(&dev) != hipSuccess || hipDeviceGetAttribute(&cus, hipDeviceAttributeMultiprocessorCount, dev) != hipSuccess) { fprintf(stderr, "mk_grid: device query failed\n"); grid = -1; return grid; }
        if (hipFuncSetAttribute((const void*)mk_fwd, hipFuncAttributeMaxDynamicSharedMemorySize, LDS_BYTES) != hipSuccess) { fprintf(stderr, "mk_grid: hipFuncSetAttribute failed\n"); grid = -1; return grid; }
        if (hipOccupancyMaxActiveBlocksPerMultiprocessor(&per_cu, (const void*)mk_fwd, NTHR, LDS_BYTES) != hipSuccess || per_cu < 1) { fprintf(stderr, "mk_grid: occupancy query says %d\n", per_cu); (void)hipGetLastError(); per_cu = 1; }
        grid = cus * 1;
    }
    return grid;
}
static void mk_launch(const Ptrs& P, int lo, int hi, hipStream_t stream) {
    const int grid = mk_grid(); if (grid <= 0) return;
    if (hipMemsetAsync(P.ws, 0, 16384, stream) != hipSuccess) { fprintf(stderr, "memset of the barrier words failed\n"); return; }
    MkArgs a{}; a.P = P; a.ph_lo = lo; a.ph_hi = hi;
    void* args[] = {&a};
    hipError_t e = hipLaunchCooperativeKernel((const void*)mk_fwd, dim3(grid), dim3(NTHR), args, LDS_BYTES, stream);
    if (e != hipSuccess) fprintf(stderr, "cooperative launch failed: %s (grid %d)\n", hipGetErrorString(e), grid);
}

extern "C" void kernel_launch(void* const* d_in, const int* in_sizes, int n_in, void* d_out, int out_size, void* d_ws, size_t ws_size, hipStream_t stream) {
    if (n_in != 20 || out_size != MTOK * DM || ws_size < 256 * MiB) { fprintf(stderr, "kernel_launch: unexpected shapes (n_in %d out %d ws %zu)\n", n_in, out_size, ws_size); return; }
    Ptrs P{};
    const float** pp = (const float**)&P;
    for (int i = 0; i < 20; ++i) pp[i] = (const float*)d_in[i];
    P.out = (float*)d_out; P.ws = (unsigned char*)d_ws;
    unsigned char* ws = P.ws;
    bf16_t *WIN = (bf16_t*)(ws + WS_WIN), *WAP = (bf16_t*)(ws + WS_WAP), *WPP = (bf16_t*)(ws + WS_WPP), *WOUT = (bf16_t*)(ws + WS_WOUT), *WUP = (bf16_t*)(ws + WS_WUP), *WDN = (bf16_t*)(ws + WS_WDN), *PW = (bf16_t*)(ws + WS_PW);
    bf16_t *H = (bf16_t*)(ws + WS_H), *Q = (bf16_t*)(ws + WS_Q), *VT = (bf16_t*)(ws + WS_VT), *VCT = (bf16_t*)(ws + WS_VCT), *POOLIN = (bf16_t*)(ws + WS_POOLIN), *GATES = (bf16_t*)(ws + WS_GATES);
    bf16_t *PG = (bf16_t*)(ws + WS_PG), *DIFF = (bf16_t*)(ws + WS_DIFF), *PM = (bf16_t*)(ws + WS_PM), *Y2 = (bf16_t*)(ws + WS_Y2), *ACT = (bf16_t*)(ws + WS_ACT);
    float *MOD = (float*)(ws + WS_MOD), *B2 = (float*)(ws + WS_B2), *SSQ = (float*)(ws + WS_SSQ);
    if (MK_LO == 0) mk_launch(P, 0, MK_HI, stream);
    if (MK_LO > 0) {   mk_launch(P, 0, 2, stream); }
    if (MK_LO == 2) mk_launch(P, MK_LO, MK_HI, stream);
    if (2 < MK_LO || 2 >= MK_HI) {
    k_qk<<<(MTOK / 64 * 20 + 3) / 4, 256, 0, stream>>>(P, 0);
    k_qk<<<(MCTX / 64 * 4 + 3) / 4, 256, 0, stream>>>(P, 1);
    { EpiInRest E{VT, POOLIN, GATES, P.gate_b}; k_gemm<EpiInRest><<<(MTOK / 64 * ((INW - 1280) / 8) + 3) / 4, 256, 0, stream>>>(H, DM, WIN + (size_t)1280 * DM, DM, MTOK, INW - 1280, DM, 1280, E); }
    { EpiCtxV E{VCT}; k_gemm<EpiCtxV><<<(MCTX / 64 * (KVW / 8) + 3) / 4, 256, 0, stream>>>(H + (size_t)MTOK * DM, DM, WIN + (size_t)1280 * DM, DM, MCTX, KVW, DM, 0, E); }
    }
    if (MK_LO == 3) mk_launch(P, MK_LO, MK_HI, stream);
    if (3 < MK_LO || 3 >= MK_HI) {
    k_attn<<<(MTOK / 64 * 16 + 3) / 4, 256, 0, stream>>>(P);
    k_diff<<<(MTOK * POOLW + 255) / 256, 256, 0, stream>>>(POOLIN, DIFF);
    for (int g = 0; g < 4; ++g) { EpiPoolMix E{PM, P.pool_scale, g}; k_gemm<EpiPoolMix><<<(MTOK / 64 * (128 / 8) + 3) / 4, 256, 0, stream>>>(DIFF + g * 128, POOLW, PW + g * 16384, 128, MTOK, 128, 128, 0, E); }
    }
    if (MK_LO == 4) mk_launch(P, MK_LO, MK_HI, stream);
    if (4 < MK_LO || 4 >= MK_HI) {
    { EpiPoolProj E{PG, GATES}; k_gemm<EpiPoolProj><<<(MTOK / 64 * (DM / 8) + 3) / 4, 256, 0, stream>>>(PM, PMP, WPP, PMP, MTOK, DM, POOLW, 0, E); }
    { EpiAttnProj E{PG, GATES}; k_gemm<EpiAttnProj><<<(MTOK / 64 * (DM / 8) + 3) / 4, 256, 0, stream>>>((bf16_t*)(ws + WS_ATT), DM, WAP, DM, MTOK, DM, DM, 0, E); }
    }
    if (MK_LO == 5) mk_launch(P, MK_LO, MK_HI, stream);
    if (5 < MK_LO || 5 >= MK_HI) {
    { EpiOut E{P.x, P.out, Y2, MOD, P.n2g}; k_gemm_out<<<(MTOK / 64 * (DM / 8) + 3) / 4, 256, 0, stream>>>(PG, WOUT, E); }
    k_ssq<<<(MTOK * 4 + 255) / 256, 256, 0, stream>>>(P.out, SSQ);
    }
    if (MK_LO == 6) mk_launch(P, MK_LO, MK_HI, stream);
    if (6 < MK_LO || 6 >= MK_HI) {
    { EpiUp E{ACT, B2}; k_gemm_up<<<(MTOK / 64 * (FF / 8) + 3) / 4, 256, 0, stream>>>(Y2, WUP, SSQ, E); }
    }
    if (MK_LO == 7) mk_launch(P, MK_LO, MK_HI, stream);
    if (7 < MK_LO || 7 >= MK_HI) {
    { EpiDown E{P.out, MOD}; k_gemm<EpiDown><<<(MTOK / 64 * (DM / 8) + 3) / 4, 256, 0, stream>>>(ACT, FF, WDN, FF, MTOK, DM, FF, 0, E); }
    }
}
```

```cpp
#include <hip/hip_runtime.h>
#include <cstdio>
#include <cstdint>

typedef unsigned short bf16_t;
typedef unsigned u32x4 __attribute__((ext_vector_type(4)));
typedef unsigned u32x2 __attribute__((ext_vector_type(2)));
typedef float f32x4 __attribute__((ext_vector_type(4)));

constexpr int NB = 4, SEQ = 4096, DM = 1024, MTOK = NB * SEQ, CTX = 256, MCTX = NB * CTX;
constexpr int INW = 4096, FF = 2816, NUP = 2 * FF, POOLW = 512, KVW = 256, NMOD = 6 * DM;
constexpr float EPS = 1e-6f, LOG2E = 1.4426950408889634f, QSCALE = 0.125f * LOG2E;

constexpr size_t MiB = 1u << 20;
constexpr size_t WS_WIN = 1 * MiB, WS_WAP = 9 * MiB, WS_WOUT = 12 * MiB, WS_WUP = 14 * MiB, WS_WDN = 25 * MiB;
constexpr size_t WS_PW = 31 * MiB, WS_MOD = 31 * MiB + 256 * 1024, WS_B2 = 31 * MiB + 512 * 1024;
constexpr size_t WS_H = 32 * MiB, WS_Q = 66 * MiB, WS_K = 98 * MiB, WS_VT = 106 * MiB, WS_KC = 114 * MiB, WS_VCT = 114 * MiB + 512 * 1024;
constexpr size_t WS_POOLIN = 115 * MiB, WS_GATES = 131 * MiB, WS_PM = 195 * MiB  , WS_SSQ = 227 * MiB, WS_WPP = 229 * MiB  ;
constexpr size_t WS_PG = 66 * MiB;
constexpr int PMP = 1024;
constexpr size_t WS_ATT = 32 * MiB  , WS_Y2 = 32 * MiB, WS_ACT = 66 * MiB, WS_DIFF = 98 * MiB  ;

struct Ptrs {
    const float *x, *c, *ctx, *c_ctx, *mod_w, *mod_b, *n1g, *n2g, *w_in, *gate_b, *qg, *kg, *sink, *pool_w, *pool_scale, *w_ap, *w_pp, *w_out, *w_up, *w_dn;
    float* out; unsigned char* ws;
};

__device__ __forceinline__ float bf2f(bf16_t v) { return __uint_as_float((unsigned)v << 16); }
__device__ __forceinline__ unsigned f2bf(float f) { unsigned u = __float_as_uint(f); return (u + 0x7fffu + ((u >> 16) & 1u)) >> 16; }
__device__ __forceinline__ unsigned pk2(float lo, float hi) { return f2bf(lo) | (f2bf(hi) << 16); }
__device__ __forceinline__ void unpack8(u32x4 w, float (&v)[8]) {
    v[0] = __uint_as_float(w.x << 16); v[1] = __uint_as_float(w.x & 0xffff0000u); v[2] = __uint_as_float(w.y << 16); v[3] = __uint_as_float(w.y & 0xffff0000u);
    v[4] = __uint_as_float(w.z << 16); v[5] = __uint_as_float(w.z & 0xffff0000u); v[6] = __uint_as_float(w.w << 16); v[7] = __uint_as_float(w.w & 0xffff0000u);
}
typedef float f32x2_t __attribute__((ext_vector_type(2))); typedef __bf16 bf16x2_t __attribute__((ext_vector_type(2)));
__device__ __forceinline__ unsigned cvtpk(float lo, float hi) { f32x2_t v = {lo, hi}; bf16x2_t b = __builtin_convertvector(v, bf16x2_t); return __builtin_bit_cast(unsigned, b); }
__device__ __forceinline__ u32x4 pack8(const float (&v)[8]) { u32x4 w; w.x = cvtpk(v[0], v[1]); w.y = cvtpk(v[2], v[3]); w.z = cvtpk(v[4], v[5]); w.w = cvtpk(v[6], v[7]); return w; }
__device__ __forceinline__ float sigmoidf_(float v) { return __builtin_amdgcn_rcpf(1.0f + __builtin_amdgcn_exp2f(-LOG2E * v)); }
__device__ __forceinline__ float siluf_(float v) { return v * __builtin_amdgcn_rcpf(1.0f + __builtin_amdgcn_exp2f(-LOG2E * v)); }
__device__ __forceinline__ int perm16(int t) { return (t & ~12) | ((t & 4) << 1) | ((t & 8) >> 1); }
__device__ __forceinline__ float wave_sum(float v) {
#pragma unroll
    for (int o = 1; o < 64; o <<= 1) v += __shfl_xor(v, o);
    return v;
}
__host__ __device__ __forceinline__ int qk_pos(int j) { const int f = j & 15; return 8 * (f >> 2) + (j < 16 ? 0 : 4) + (f & 3); }
__host__ __device__ __forceinline__ int qk_row(int tile, int hd, int d) { return tile * 256 + 128 * (d >> 5) + 32 * hd + qk_pos(d & 31); }
__host__ __device__ __forceinline__ int up_src_col(int np) { const int tile = np >> 8, r = np & 255; return r < 128 ? tile * 128 + r : FF + tile * 128 + (r - 128); }

struct EpiInRest {
    bf16_t *Vt, *POOLIN, *GATES; const float* gate_b;
    __device__ __forceinline__ void operator()(int row, int c0, const float (&v)[8]) const {
        if (c0 < 1536) {
            const int b = row >> 12, t = row & 4095, cv = c0 - 1280, kh = cv >> 6, d0 = cv & 63;
            bf16_t* p = Vt + ((size_t)((b * 4 + kh) * 64 + d0)) * SEQ + perm16(t);
#pragma unroll
            for (int i = 0; i < 8; ++i) p[(size_t)i * SEQ] = (bf16_t)f2bf(v[i]);
        } else if (c0 < 2048) {
            *(u32x4*)(POOLIN + (size_t)row * POOLW + (c0 - 1536)) = pack8(v);
        } else {
            const int s = c0 - 2048, gc = ((s >> 7) & 1) * 1024 + ((s >> 8) << 7) + (s & 127); float g[8];
#pragma unroll
            for (int i = 0; i < 8; ++i) g[i] = sigmoidf_(v[i] + gate_b[gc + i]);
            *(u32x4*)(GATES + (size_t)row * 2048 + gc) = pack8(g);
        }
    }
};
struct EpiCtxV {
    bf16_t* Vct;
    __device__ __forceinline__ void operator()(int row, int c0, const float (&v)[8]) const {
        const int b = row >> 8, t = row & 255, kh = c0 >> 6, d0 = c0 & 63;
        bf16_t* p = Vct + ((size_t)((b * 4 + kh) * 64 + d0)) * CTX + perm16(t);
#pragma unroll
        for (int i = 0; i < 8; ++i) p[(size_t)i * CTX] = (bf16_t)f2bf(v[i]);
    }
};
struct EpiPoolMix {
    bf16_t* PM; const float* pool_scale; int g;
    __device__ __forceinline__ void operator()(int row, int c0, const float (&v)[8]) const {
        float o[8];
#pragma unroll
        for (int i = 0; i < 8; ++i) o[i] = v[i] * pool_scale[g * 128 + c0 + i];
        *(u32x4*)(PM + (size_t)row * PMP + g * 128 + c0) = pack8(o);
    }
};
struct EpiPoolProj {
    bf16_t* PG; const bf16_t* GATES;
    __device__ __forceinline__ void operator()(int row, int c0, const float (&v)[8]) const {
        float g[8], o[8]; unpack8(*(const u32x4*)(GATES + (size_t)row * 2048 + 1024 + c0), g);
#pragma unroll
        for (int i = 0; i < 8; ++i) o[i] = g[i] * v[i];
        *(u32x4*)(PG + (size_t)row * DM + c0) = pack8(o);
    }
};
struct EpiAttnProj {
    bf16_t* PG; const bf16_t* GATES;
    __device__ __forceinline__ void operator()(int row, int c0, const float (&v)[8]) const {
        float g[8], p[8], o[8]; unpack8(*(const u32x4*)(GATES + (size_t)row * 2048 + c0), g); unpack8(*(const u32x4*)(PG + (size_t)row * DM + c0), p);
#pragma unroll
        for (int i = 0; i < 8; ++i) o[i] = g[i] * v[i] + p[i];
        *(u32x4*)(PG + (size_t)row * DM + c0) = pack8(o);
    }
};
struct EpiOut {
    const float* x; float* out; bf16_t* Y2; const float* mod; const float* n2g;
    __device__ __forceinline__ float operator()(int row, int c0, const float (&v)[8]) const {
        const int b = row >> 12; const float* mb = mod + (size_t)b * NMOD; float o[8], y[8], ss = 0.f;
#pragma unroll
        for (int h = 0; h < 2; ++h) {
            const f32x4 xv = *(const f32x4*)(x + (size_t)row * DM + c0 + 4 * h), g1 = *(const f32x4*)(mb + 2 * DM + c0 + 4 * h), sc2 = *(const f32x4*)(mb + 4 * DM + c0 + 4 * h), ng = *(const f32x4*)(n2g + c0 + 4 * h);
#pragma unroll
            for (int i = 0; i < 4; ++i) { const float x1 = xv[i] + g1[i] * v[4 * h + i]; o[4 * h + i] = x1; ss += x1 * x1; y[4 * h + i] = x1 * (ng[i] * (1.0f + sc2[i])); }
            *(f32x4*)(out + (size_t)row * DM + c0 + 4 * h) = (f32x4){o[4 * h], o[4 * h + 1], o[4 * h + 2], o[4 * h + 3]};
        }
        *(u32x4*)(Y2 + (size_t)row * DM + c0) = pack8(y);
        return ss;
    }
};
struct EpiUp {
    bf16_t* ACT; const float* bias2;
    __device__ __forceinline__ void operator()(int row, int c0, float rstd, const float (&va)[8], const float (&vb)[8]) const {
        const int b = row >> 12, np = ((c0 >> 7) << 8) + (c0 & 127); const float* bb = bias2 + (size_t)b * NUP + np; float o[8];
#pragma unroll
        for (int i = 0; i < 8; ++i) { const float a = rstd * va[i] + bb[i], g = rstd * vb[i] + bb[128 + i]; o[i] = siluf_(a) * g; }
        *(u32x4*)(ACT + (size_t)row * FF + c0) = pack8(o);
    }
};
struct EpiDown {
    float* out; const float* mod; float* dump = nullptr;
    __device__ __forceinline__ void operator()(int row, int c0, const float (&v)[8]) const {
        const int b = row >> 12; const float* g2 = mod + (size_t)b * NMOD + 5 * DM + c0;
#pragma unroll
        for (int h = 0; h < 2; ++h) { f32x4 xv = *(const f32x4*)(out + (size_t)row * DM + c0 + 4 * h); const f32x4 g = *(const f32x4*)(g2 + 4 * h);
#pragma unroll
            for (int i = 0; i < 4; ++i) xv[i] += g[i] * v[4 * h + i];
            if (dump) *(f32x4*)(dump + (((size_t)row * DM + c0 + 4 * h) & (size_t)0x7fffff)) = xv; else *(f32x4*)(out + (size_t)row * DM + c0 + 4 * h) = xv; }
    }
};
__device__ __forceinline__ float row_rstd(const float* SSQ, int row) {
    const f32x4 v = *(const f32x4*)(SSQ + (size_t)row * 4);
    return __builtin_amdgcn_rsqf(((v[0] + v[1]) + (v[2] + v[3])) * (1.0f / DM) + EPS);
}

__device__ __forceinline__ void h_row(const float* xrow, const float* g, const float* sh, const float* sc, bf16_t* orow, int lane) {
    const f32x4* xr = (const f32x4*)xrow + lane; f32x4 v[4]; float s = 0.f;
#pragma unroll
    for (int j = 0; j < 4; ++j) { v[j] = xr[64 * j]; s += (v[j][0] * v[j][0] + v[j][1] * v[j][1]) + (v[j][2] * v[j][2] + v[j][3] * v[j][3]); }
    const float rstd = 1.0f / sqrtf(wave_sum(s) * (1.0f / DM) + EPS);
#pragma unroll
    for (int j = 0; j < 4; ++j) {
        const f32x4 gg = ((const f32x4*)g + lane)[64 * j], s1 = ((const f32x4*)sh + lane)[64 * j], c1 = ((const f32x4*)sc + lane)[64 * j]; float o[4];
#pragma unroll
        for (int i = 0; i < 4; ++i) o[i] = (v[j][i] * rstd * gg[i]) * (1.0f + c1[i]) + s1[i];
        u32x2 w; w.x = pk2(o[0], o[1]); w.y = pk2(o[2], o[3]);
        ((u32x2*)orow + lane)[64 * j] = w;
    }
}
__device__ __forceinline__ void bias2_row(const bf16_t* wrow, const float* mod, float* bias2, int np, int lane) {
    float w[16]; { float t[8]; unpack8(*(const u32x4*)(wrow + lane * 16), t);
#pragma unroll
        for (int i = 0; i < 8; ++i) w[i] = t[i];
        unpack8(*(const u32x4*)(wrow + lane * 16 + 8), t);
#pragma unroll
        for (int i = 0; i < 8; ++i) w[8 + i] = t[i]; }
#pragma unroll
    for (int b = 0; b < 4; ++b) { const float* sh2 = mod + (size_t)b * NMOD + 3 * DM + lane * 16; float s = 0.f;
#pragma unroll
        for (int i = 0; i < 16; ++i) s += sh2[i] * w[i];
        s = wave_sum(s); if (lane == 0) bias2[(size_t)b * NUP + np] = s; }
}

__global__ void k_transpose(const float* W, int K, int N, bf16_t* WT, int upmode) {
    const size_t total = (size_t)K * N;
    for (size_t idx = (size_t)blockIdx.x * blockDim.x + threadIdx.x; idx < total; idx += (size_t)gridDim.x * blockDim.x) {
        const int np = (int)(idx / K), k = (int)(idx % K); const int n = upmode ? up_src_col(np) : np;
        WT[idx] = (bf16_t)f2bf(W[(size_t)k * N + n]);
    }
}
__global__ void k_mod(Ptrs P) {
    const int idx = blockIdx.x * blockDim.x + threadIdx.x; if (idx >= 5 * NMOD) return;
    const int r = idx / NMOD, n = idx % NMOD; const float* cv = r < 4 ? P.c + (size_t)r * DM : P.c_ctx; float s = 0.f;
    for (int k = 0; k < DM; ++k) s += siluf_(cv[k]) * P.mod_w[(size_t)k * NMOD + n];
    ((float*)(P.ws + WS_MOD))[idx] = s + P.mod_b[n];
}
__global__ void k_rows(Ptrs P) {
    const int gw = (blockIdx.x * blockDim.x + threadIdx.x) >> 6, nw = (gridDim.x * blockDim.x) >> 6, lane = threadIdx.x & 63;
    const float* mod = (const float*)(P.ws + WS_MOD); bf16_t* H = (bf16_t*)(P.ws + WS_H);
    for (int m = gw; m < MTOK + MCTX; m += nw) {
        const float* xr = m < MTOK ? P.x + (size_t)m * DM : P.ctx + (size_t)(m - MTOK) * DM; const float* mb = mod + (size_t)(m < MTOK ? (m >> 12) : 4) * NMOD;
        h_row(xr, P.n1g, mb, mb + DM, H + (size_t)m * DM, lane);
    }
    for (int np = gw; np < NUP; np += nw) bias2_row((const bf16_t*)(P.ws + WS_WUP) + (size_t)np * DM, mod, (float*)(P.ws + WS_B2), np, lane);
}
template <class Epi> __global__ void k_gemm(const bf16_t* A, int lda, const bf16_t* Bt, int ldb, int Mrows, int N, int K, int col_off, Epi E) {
    const int gw = (blockIdx.x * blockDim.x + threadIdx.x) >> 6, lane = threadIdx.x & 63, nrb = Mrows / 64;
    if (gw >= nrb * (N / 8)) return;
    const int row = (gw % nrb) * 64 + lane, c0 = (gw / nrb) * 8;
    float acc[8];
#pragma unroll
    for (int j = 0; j < 8; ++j) acc[j] = 0.f;
    for (int k0 = 0; k0 < K; k0 += 8) {
        float a[8]; unpack8(*(const u32x4*)(A + (size_t)row * lda + k0), a);
#pragma unroll
        for (int j = 0; j < 8; ++j) { float b[8]; unpack8(*(const u32x4*)(Bt + (size_t)(c0 + j) * ldb + k0), b);
#pragma unroll
            for (int i = 0; i < 8; ++i) acc[j] += a[i] * b[i]; }
    }
    E(row, c0 + col_off, acc);
}
__global__ void k_gemm_out(const bf16_t* A, const bf16_t* Bt, EpiOut E) {
    const int gw = (blockIdx.x * blockDim.x + threadIdx.x) >> 6, lane = threadIdx.x & 63, nrb = MTOK / 64;
    if (gw >= nrb * (DM / 8)) return;
    const int row = (gw % nrb) * 64 + lane, c0 = (gw / nrb) * 8;
    float acc[8];
#pragma unroll
    for (int j = 0; j < 8; ++j) acc[j] = 0.f;
    for (int k0 = 0; k0 < DM; k0 += 8) {
        float a[8]; unpack8(*(const u32x4*)(A + (size_t)row * DM + k0), a);
#pragma unroll
        for (int j = 0; j < 8; ++j) { float b[8]; unpack8(*(const u32x4*)(Bt + (size_t)(c0 + j) * DM + k0), b);
#pragma unroll
            for (int i = 0; i < 8; ++i) acc[j] += a[i] * b[i]; }
    }
    (void)E(row, c0, acc);
}
__global__ void k_ssq(const float* out, float* SSQ) {
    const int idx = blockIdx.x * blockDim.x + threadIdx.x; if (idx >= MTOK * 4) return;
    const float* p = out + (size_t)(idx >> 2) * DM + (idx & 3) * 256; float s = 0.f;
    for (int i = 0; i < 256; ++i) s += p[i] * p[i];
    SSQ[idx] = s;
}
__global__ void k_gemm_up(const bf16_t* A, const bf16_t* Bt, const float* SSQ, EpiUp E) {
    const int gw = (blockIdx.x * blockDim.x + threadIdx.x) >> 6, lane = threadIdx.x & 63, nrb = MTOK / 64;
    if (gw >= nrb * (FF / 8)) return;
    const int row = (gw % nrb) * 64 + lane, c0 = (gw / nrb) * 8, np = ((c0 >> 7) << 8) + (c0 & 127);
    float aa[8], ab[8];
#pragma unroll
    for (int j = 0; j < 8; ++j) { aa[j] = 0.f; ab[j] = 0.f; }
    for (int k0 = 0; k0 < DM; k0 += 8) {
        float a[8]; unpack8(*(const u32x4*)(A + (size_t)row * DM + k0), a);
#pragma unroll
        for (int j = 0; j < 8; ++j) { float b[8]; unpack8(*(const u32x4*)(Bt + (size_t)(np + j) * DM + k0), b);
#pragma unroll
            for (int i = 0; i < 8; ++i) aa[j] += a[i] * b[i];
            unpack8(*(const u32x4*)(Bt + (size_t)(np + 128 + j) * DM + k0), b);
#pragma unroll
            for (int i = 0; i < 8; ++i) ab[j] += a[i] * b[i]; }
    }
    E(row, c0, row_rstd(SSQ, row), aa, ab);
}
__global__ void __launch_bounds__(256) k_qk(Ptrs P, int ctxmode) {
    const int gw = (blockIdx.x * blockDim.x + threadIdx.x) >> 6, lane = threadIdx.x & 63;
    const int nrows = ctxmode ? MCTX : MTOK, nrb = nrows / 64, nheads = ctxmode ? 4 : 20;
    if (gw >= nrb * nheads) return;
    const int row = (gw % nrb) * 64 + lane, hh = gw / nrb;
    const bool isq = !ctxmode && hh < 16; const int wtile = (ctxmode || hh >= 16) ? 4 : hh >> 2, whd = hh & 3;
    const bf16_t* A = (const bf16_t*)(P.ws + WS_H) + (size_t)(ctxmode ? MTOK + row : row) * DM; const bf16_t* Bt = (const bf16_t*)(P.ws + WS_WIN);
    float acc[64];
#pragma unroll
    for (int j = 0; j < 64; ++j) acc[j] = 0.f;
    for (int k0 = 0; k0 < DM; k0 += 8) {
        float a[8]; unpack8(*(const u32x4*)(A + k0), a);
#pragma unroll
        for (int j = 0; j < 64; ++j) { float b[8]; unpack8(*(const u32x4*)(Bt + (size_t)qk_row(wtile, whd, j) * DM + k0), b);
#pragma unroll
            for (int i = 0; i < 8; ++i) acc[j] += a[i] * b[i]; }
    }
    float ss = 0.f;
#pragma unroll
    for (int j = 0; j < 64; ++j) ss += acc[j] * acc[j];
    const float rstd = 1.0f / sqrtf(ss * (1.0f / 64.0f) + EPS); const float* g = isq ? P.qg : P.kg;
#pragma unroll
    for (int j = 0; j < 64; ++j) acc[j] = acc[j] * rstd * g[j];
    bf16_t* dst;
    if (ctxmode) dst = (bf16_t*)(P.ws + WS_KC) + (size_t)row * KVW + hh * 64;
    else {
        const int t = row & 4095;
#pragma unroll
        for (int a = 0; a < 2; ++a) { const float pos = (float)(a ? (t & 63) : (t >> 6));
#pragma unroll
            for (int f = 0; f < 16; ++f) { const float ang = pos * exp2f(-(float)f * (13.287712379549449f / 16.0f)); float sn, cs; sincosf(ang, &sn, &cs);
                const float x1 = acc[32 * a + f], x2 = acc[32 * a + 16 + f]; acc[32 * a + f] = x1 * cs - x2 * sn; acc[32 * a + 16 + f] = x2 * cs + x1 * sn; } }
        if (isq) {
#pragma unroll
            for (int j = 0; j < 64; ++j) acc[j] *= QSCALE;
            dst = (bf16_t*)(P.ws + WS_Q) + (size_t)row * DM + hh * 64;
        } else dst = (bf16_t*)(P.ws + WS_K) + (size_t)row * KVW + (hh - 16) * 64;
    }
#pragma unroll
    for (int j = 0; j < 64; j += 8) { float o[8];
#pragma unroll
        for (int i = 0; i < 8; ++i) o[i] = acc[j + i];
        *(u32x4*)(dst + j) = pack8(o); }
}
__global__ void __launch_bounds__(256) k_attn(Ptrs P) {
    const int gw = (blockIdx.x * blockDim.x + threadIdx.x) >> 6, lane = threadIdx.x & 63, nrb = MTOK / 64;
    if (gw >= nrb * 16) return;
    const int row = (gw % nrb) * 64 + lane, h = gw / nrb, kh = h >> 2, b = row >> 12, t = row & 4095;
    bf16_t* Qp = (bf16_t*)(P.ws + WS_Q) + (size_t)row * DM + h * 64;
    const bf16_t* Kb = (const bf16_t*)(P.ws + WS_K) + (size_t)b * SEQ * KVW + kh * 64; const bf16_t* Vb = (const bf16_t*)(P.ws + WS_VT) + (size_t)(b * 4 + kh) * 64 * SEQ;
    const bf16_t* Kc = (const bf16_t*)(P.ws + WS_KC) + (size_t)b * CTX * KVW + kh * 64; const bf16_t* Vc = (const bf16_t*)(P.ws + WS_VCT) + (size_t)(b * 4 + kh) * 64 * CTX;
    float q[64], o[64];
#pragma unroll
    for (int j = 0; j < 64; j += 8) { float tq[8]; unpack8(*(const u32x4*)(Qp + j), tq);
#pragma unroll
        for (int i = 0; i < 8; ++i) { q[j + i] = tq[i]; o[j + i] = 0.f; } }
    const float sink2 = P.sink[h] * LOG2E; float m = sink2;
    const int jlo = t - 128 < 0 ? 0 : t - 128, jhi = t + 128 > SEQ - 1 ? SEQ - 1 : t + 128;
    for (int pass = 0; pass < 2; ++pass) {
        float den = 0.f;
        for (int kk = jlo; kk <= jhi + CTX; ++kk) {
            const bool isc = kk > jhi; const int j = isc ? kk - jhi - 1 : kk; const bf16_t* kp = isc ? Kc + (size_t)j * KVW : Kb + (size_t)j * KVW;
            float s = 0.f;
#pragma unroll
            for (int d8 = 0; d8 < 64; d8 += 8) { float kv[8]; unpack8(*(const u32x4*)(kp + d8), kv);
#pragma unroll
                for (int i = 0; i < 8; ++i) s += q[d8 + i] * kv[i]; }
            if (pass == 0) m = fmaxf(m, s);
            else { const float p = exp2f(s - m); den += p; const bf16_t* vp = isc ? Vc + perm16(j) : Vb + perm16(j); const int pitch = isc ? CTX : SEQ;
#pragma unroll
                for (int d = 0; d < 64; ++d) o[d] += p * bf2f(vp[(size_t)d * pitch]); }
        }
        if (pass == 1) { den += exp2f(sink2 - m); const float inv = 1.0f / den;
#pragma unroll
            for (int j = 0; j < 64; j += 8) { float w[8];
#pragma unroll
                for (int i = 0; i < 8; ++i) w[i] = o[j + i] * inv;
                *(u32x4*)((bf16_t*)(P.ws + WS_ATT) + (size_t)row * DM + h * 64 + j) = pack8(w); } }
    }
}
__global__ void k_diff(const bf16_t* POOLIN, bf16_t* DIFF) {
    const int idx = blockIdx.x * blockDim.x + threadIdx.x; if (idx >= MTOK * POOLW) return;
    const int row = idx / POOLW, ch = idx % POOLW, g = ch >> 7, w2 = 1 << g, t = row & 4095, base = row - t;
    const int lo = t - w2 < 0 ? 0 : t - w2, hi = t + w2 > SEQ ? SEQ : t + w2; float s = 0.f;
    for (int j = lo; j < hi; ++j) s += bf2f(POOLIN[(size_t)(base + j) * POOLW + ch]);
    DIFF[idx] = (bf16_t)f2bf(s / (float)(hi - lo) - bf2f(POOLIN[idx]));
}


#include <hip/hip_cooperative_groups.h>
namespace cg = cooperative_groups;
#define LAS __attribute__((address_space(3)))
#define LDS_WAIT() asm volatile("s_waitcnt lgkmcnt(0)" ::: "memory")
constexpr int NWAVES = 8, NTHR = NWAVES * 64;
constexpr int LDS_BYTES = 147456 + 256;
constexpr int RING_BYTES = 131072;

#ifndef MK_HI
#define MK_HI 8
#endif
#ifndef MK_LO
#define MK_LO 0
#endif
#ifndef MK_DBL
#define MK_DBL -1
#endif
#ifndef MK_SYNCX
#define MK_SYNCX 0
#endif
struct MkArgs { Ptrs P; int ph_lo, ph_hi; };

__device__ __forceinline__ void p0_transpose_item(const float* W, int K, int N, bf16_t* WT, int upmode, LAS float* scr, int item, int lane, int ldo = 0, bool qkperm = false) {
    ldo = ldo ? ldo : K;
    const int nblk = N / 32, kb = item / nblk, nb = item % nblk, k0 = 64 * kb, n0 = 32 * nb;
#pragma unroll 8
    for (int i = 0; i < 32; ++i) { const int kk = 2 * i + (lane >> 5); scr[kk * 33 + (lane & 31)] = __builtin_nontemporal_load(W + (size_t)(k0 + kk) * N + n0 + (lane & 31)); }
    LDS_WAIT(); asm volatile("" ::: "memory");
    int r0 = n0;
    if (upmode) r0 = n0 < FF ? ((n0 >> 7) << 8) + (n0 & 127) : (((n0 - FF) >> 7) << 8) + 128 + ((n0 - FF) & 127);
    const int c = lane & 7;
#pragma unroll
    for (int j = 0; j < 4; ++j) { const int n = (lane >> 3) + 8 * j; const LAS float* s = scr + (8 * c) * 33 + n;
        u32x4 o; o.x = pk2(s[0 * 33], s[1 * 33]); o.y = pk2(s[2 * 33], s[3 * 33]); o.z = pk2(s[4 * 33], s[5 * 33]); o.w = pk2(s[6 * 33], s[7 * 33]);
        int rowd = r0 + n;
        if (qkperm && n0 < 1280) rowd = (n0 & ~255) + 128 * ((n0 >> 5) & 1) + 32 * ((n0 >> 6) & 3) + qk_pos(n);
        else if (qkperm && n0 >= 2048) { const int gcol = n0 - 2048 + n, half = gcol >> 10, c = gcol & 1023; rowd = 2048 + ((c >> 7) << 8) + 128 * half + (c & 127); }
        *(u32x4*)(WT + (size_t)rowd * ldo + k0 + 8 * c) = o; }
    LDS_WAIT(); asm volatile("" ::: "memory");
}

__device__ __forceinline__ void mk_p0(const Ptrs& P, LAS unsigned char* lds, int tid, int wave, int lane, int bx, int G) {
    unsigned char* ws = P.ws;
    LAS float* scr = (LAS float*)(lds + wave * 16384);
    const int gw = bx * NWAVES + wave, NGW = G * NWAVES;
    constexpr int I_IN = (DM / 64) * (INW / 32), I_AP = (DM / 64) * (DM / 32), I_PP = (POOLW / 64) * (DM / 32), I_OUT = I_AP, I_UP = (DM / 64) * (NUP / 32), I_DN = (FF / 64) * (DM / 32), I_PW = 4 * 2 * 4;
    constexpr int NITEMS = I_IN + I_AP + I_PP + I_OUT + I_UP + I_DN + I_PW;
    for (int it = gw; it < NITEMS; it += NGW) {
        int r = it;
        if (r < I_IN) { p0_transpose_item(P.w_in, DM, INW, (bf16_t*)(ws + WS_WIN), 0, scr, r, lane, 0, true); continue; } r -= I_IN;
        if (r < I_AP) { p0_transpose_item(P.w_ap, DM, DM, (bf16_t*)(ws + WS_WAP), 0, scr, r, lane); continue; } r -= I_AP;
        if (r < I_PP) { p0_transpose_item(P.w_pp, POOLW, DM, (bf16_t*)(ws + WS_WPP), 0, scr, r, lane, PMP); continue; } r -= I_PP;
        if (r < I_OUT) { p0_transpose_item(P.w_out, DM, DM, (bf16_t*)(ws + WS_WOUT), 0, scr, r, lane); continue; } r -= I_OUT;
        if (r < I_UP) { p0_transpose_item(P.w_up, DM, NUP, (bf16_t*)(ws + WS_WUP), 1, scr, r, lane); continue; } r -= I_UP;
        if (r < I_DN) { p0_transpose_item(P.w_dn, FF, DM, (bf16_t*)(ws + WS_WDN), 0, scr, r, lane); continue; } r -= I_DN;
        { const int g = r >> 3; p0_transpose_item(P.pool_w + g * 16384, 128, 128, (bf16_t*)(ws + WS_PW) + g * 16384, 0, scr, r & 7, lane); }
    }
    for (int cgp = bx; cgp < NMOD / 32; cgp += G) {
        LAS float* sl = (LAS float*)(lds + RING_BYTES);
        __syncthreads();
        sl = (LAS float*)lds;
        LAS float* red = (LAS float*)(lds + 32768);
        for (int i = tid; i < 5 * DM; i += NTHR) { const int r = i >> 10, k = i & 1023; sl[i] = siluf_(r < 4 ? P.c[(size_t)r * DM + k] : P.c_ctx[k]); }
        __syncthreads();
        const int col = lane & 31, half = lane >> 5; float acc[5] = {0.f, 0.f, 0.f, 0.f, 0.f};
        const float* wp = P.mod_w + (size_t)(128 * wave + half) * NMOD + 32 * cgp + col;
#pragma unroll 8
        for (int i = 0; i < 64; ++i) { const float wv = __builtin_nontemporal_load(wp + (size_t)(2 * i) * NMOD); const int k = 128 * wave + 2 * i + half;
#pragma unroll
            for (int r = 0; r < 5; ++r) acc[r] += sl[r * DM + k] * wv; }
#pragma unroll
        for (int r = 0; r < 5; ++r) red[((wave * 2 + half) * 5 + r) * 32 + col] = acc[r];
        __syncthreads();
        if (tid < 160) { const int r = tid >> 5, c = tid & 31; float s = 0.f;
#pragma unroll
            for (int p = 0; p < 16; ++p) s += red[(p * 5 + r) * 32 + c];
            ((float*)(ws + WS_MOD))[(size_t)r * NMOD + 32 * cgp + c] = s + P.mod_b[32 * cgp + c]; }
        __syncthreads();
    }
}
template <int NR> __device__ __forceinline__ void h_rows(const float* xbase, const f32x4 (&A)[4], const f32x4 (&Bv)[4], bf16_t* obase, int lane) {
    f32x4 v[NR][4]; float s[NR];
#pragma unroll
    for (int r = 0; r < NR; ++r)
#pragma unroll
        for (int j = 0; j < 4; ++j) v[r][j] = __builtin_nontemporal_load((const f32x4*)(xbase + (size_t)r * DM) + lane + 64 * j);
#pragma unroll
    for (int r = 0; r < NR; ++r) { s[r] = 0.f;
#pragma unroll
        for (int j = 0; j < 4; ++j) s[r] += (v[r][j][0] * v[r][j][0] + v[r][j][1] * v[r][j][1]) + (v[r][j][2] * v[r][j][2] + v[r][j][3] * v[r][j][3]); }
#pragma unroll
    for (int o = 1; o < 64; o <<= 1)
#pragma unroll
        for (int r = 0; r < NR; ++r) s[r] += __shfl_xor(s[r], o);
#pragma unroll
    for (int r = 0; r < NR; ++r) { const float rs = __builtin_amdgcn_rsqf(s[r] * (1.0f / DM) + EPS);
#pragma unroll
        for (int j = 0; j < 4; ++j) { u32x2 w; w.x = cvtpk(v[r][j][0] * rs * A[j][0] + Bv[j][0], v[r][j][1] * rs * A[j][1] + Bv[j][1]); w.y = cvtpk(v[r][j][2] * rs * A[j][2] + Bv[j][2], v[r][j][3] * rs * A[j][3] + Bv[j][3]);
            ((u32x2*)(obase + (size_t)r * DM) + lane)[64 * j] = w; } }
}
__device__ __forceinline__ void h_factors(const float* g, const float* sh, const float* sc, f32x4 (&A)[4], f32x4 (&Bv)[4], int lane) {
#pragma unroll
    for (int j = 0; j < 4; ++j) { const f32x4 gg = ((const f32x4*)g + lane)[64 * j], c1 = ((const f32x4*)sc + lane)[64 * j]; Bv[j] = ((const f32x4*)sh + lane)[64 * j];
#pragma unroll
        for (int i = 0; i < 4; ++i) A[j][i] = gg[i] * (1.0f + c1[i]); }
}
template <int NP> __device__ __forceinline__ void bias2_rows(const bf16_t* WUP, const float* mod, float* bias2, int np0, int stride, int lane) {
    u32x4 wraw[NP][2];
#pragma unroll
    for (int p = 0; p < NP; ++p) { const int np = np0 + p * stride < NUP ? np0 + p * stride : np0; wraw[p][0] = *(const u32x4*)(WUP + (size_t)np * DM + lane * 16); wraw[p][1] = *(const u32x4*)(WUP + (size_t)np * DM + lane * 16 + 8); }
    float acc[NP][4];
#pragma unroll
    for (int p = 0; p < NP; ++p)
#pragma unroll
        for (int b = 0; b < 4; ++b) acc[p][b] = 0.f;
#pragma unroll
    for (int b = 0; b < 4; ++b) { const float* sh2 = mod + (size_t)b * NMOD + 3 * DM + lane * 16; float sv[16];
#pragma unroll
        for (int q = 0; q < 4; ++q) { const f32x4 t = *(const f32x4*)(sh2 + 4 * q); sv[4 * q] = t[0]; sv[4 * q + 1] = t[1]; sv[4 * q + 2] = t[2]; sv[4 * q + 3] = t[3]; }
#pragma unroll
        for (int p = 0; p < NP; ++p) { float w[8];
            unpack8(wraw[p][0], w);
#pragma unroll
            for (int i = 0; i < 8; ++i) acc[p][b] += sv[i] * w[i];
            unpack8(wraw[p][1], w);
#pragma unroll
            for (int i = 0; i < 8; ++i) acc[p][b] += sv[8 + i] * w[i]; } }
#pragma unroll
    for (int o = 1; o < 64; o <<= 1)
#pragma unroll
        for (int p = 0; p < NP; ++p)
#pragma unroll
            for (int b = 0; b < 4; ++b) acc[p][b] += __shfl_xor(acc[p][b], o);
    if (lane == 0) {
#pragma unroll
        for (int p = 0; p < NP; ++p) if (np0 + p * stride < NUP) {
#pragma unroll
            for (int b = 0; b < 4; ++b) bias2[(size_t)b * NUP + np0 + p * stride] = acc[p][b]; } }
}
__device__ __forceinline__ void mk_p1(const Ptrs& P, int wave, int lane, int bx, int G) {
    const int gw = bx * NWAVES + wave, NGW = G * NWAVES;
    const float* mod = (const float*)(P.ws + WS_MOD); bf16_t* H = (bf16_t*)(P.ws + WS_H);
    f32x4 A[4], Bv[4];
    for (int m0 = gw * 8; m0 < MTOK; m0 += NGW * 8) { const float* mb = mod + (size_t)(m0 >> 12) * NMOD; h_factors(P.n1g, mb, mb + DM, A, Bv, lane);
        h_rows<4>(P.x + (size_t)m0 * DM, A, Bv, H + (size_t)m0 * DM, lane); h_rows<4>(P.x + (size_t)(m0 + 4) * DM, A, Bv, H + (size_t)(m0 + 4) * DM, lane); }
    for (int m0 = gw * 2; m0 < MCTX; m0 += NGW * 2) { const float* mb = mod + (size_t)4 * NMOD; h_factors(P.n1g, mb, mb + DM, A, Bv, lane); h_rows<2>(P.ctx + (size_t)m0 * DM, A, Bv, H + (size_t)(MTOK + m0) * DM, lane); }
    for (int np = gw; np < NUP; np += 3 * NGW) bias2_rows<3>((const bf16_t*)(P.ws + WS_WUP), mod, (float*)(P.ws + WS_B2), np, NGW, lane);
}

namespace pg8 {
#define PG8_LAS __attribute__((address_space(3)))
typedef unsigned short bf16_t;
typedef short bf16x8 __attribute__((ext_vector_type(8)));
typedef float f32x4 __attribute__((ext_vector_type(4)));
typedef unsigned u32x4 __attribute__((ext_vector_type(4)));
constexpr int BM = 256, BK = 64, HALF = 128, HTB = HALF * BK * 2  , STAGE_BYTES = 8 * HTB, NXCD = 8, WGM = 8;

__host__ __device__ __forceinline__ int lds_byte(int r, int c) { const int st = (r >> 4) * 2 + (c >> 5), rr = r & 15, cc = c & 31, ob = rr * 64 + cc * 2; return st * 1024 + (ob ^ (((ob >> 9) & 1) << 5)); }
__host__ __device__ __forceinline__ void stage_rc(int b, int& R, int& C) { const int st = b / 1024, sb = b % 1024, swz = sb ^ (((sb >> 9) & 1) << 5); R = (st >> 1) * 16 + swz / 64; C = (st & 1) * 32 + (swz % 64) / 2; }
__host__ __device__ __forceinline__ int perm32(int rho) { const int n = rho >> 4, i = rho & 15; return 8 * (i >> 2) + 4 * n + (i & 3); }

struct Unit { int pm, pn, seg; };
struct Gemm { const bf16_t* A; const bf16_t* Bt; int M, N, K; const bf16_t* A0 = nullptr; const bf16_t* Bt0 = nullptr; int K0 = 0; };
template <class E> struct TwoSeg { static constexpr bool v = false; };

struct StaticOrder {
    int nM, nN, nwg, G, c;
    __host__ __device__ void init(int M, int N, int G_, int c_) { nM = M / BM; nN = N / BM; nwg = nM * nN; G = G_; c = c_; }
    __host__ __device__ bool next(int i, Unit& u) const {
        const long L = (long)i * G + c; if (L >= nwg) return false;
        int wgid = (int)L; { const int q = nwg / NXCD, r = nwg % NXCD, xcd = wgid % NXCD, off = wgid / NXCD; wgid = (xcd < r ? xcd * (q + 1) : r * (q + 1) + (xcd - r) * q) + off; }
        const int nig = WGM * nN, gid = wgid / nig, fm = gid * WGM, gsz = (nM - fm) < WGM ? (nM - fm) : WGM;
        u.pm = fm + ((wgid % nig) % gsz); u.pn = (wgid % nig) / gsz; u.seg = 0; return true;
    }
    __device__ __forceinline__ void a_ready(const Unit&) const {}
    __device__ __forceinline__ void done(const Unit&) const {}
};

__device__ __forceinline__ unsigned cvt_pk_bf16(float lo, float hi) { unsigned r; asm volatile("v_cvt_pk_bf16_f32 %0, %1, %2" : "=v"(r) : "v"(lo), "v"(hi)); return r; }
template <class Epi, class Sched, bool ALIGN_EPI = false, bool SP2 = false>
__device__ __forceinline__ void gemm_phase(PG8_LAS unsigned char* lds, const Gemm g, const Sched& S, const Epi& E) {
    const int tid = threadIdx.x, wid = __builtin_amdgcn_readfirstlane(tid >> 6), lane = tid & 63, wr = wid >> 2, wc = wid & 3, fr = lane & 15, fq = lane >> 4;
    const int K = g.K, nt1 = K / BK, nt0 = g.K0 ? g.K0 / BK : nt1;
    unsigned voffA[2], voffB[2];
#pragma unroll
    for (int i = 0; i < 2; ++i) { int R, C; stage_rc(tid * 16 + i * 8192, R, C); const int Rb = Epi::PERM ? ((R & ~31) + perm32(R & 31)) : R;
        voffA[i] = (unsigned)(R * K + C) * 2u; voffB[i] = (unsigned)(Rb * K + C) * 2u; }
    const size_t kstep = (size_t)(BK * 2);
    const size_t hstep = (size_t)HALF * K * 2;
    const size_t tstep = 2 * hstep;
    const unsigned ldsw = (unsigned)wid * 1024u;
    const int aoff = lds_byte(wr * 64 + fr, fq * 8), boff = lds_byte(wc * 32 + fr, fq * 8);
#define PG8_SA(b, h) (((b) * 2 + (h)) * HTB)
#define PG8_SB(b, h) ((4 + (b) * 2 + (h)) * HTB)
#define PG8_STAGE(bufoff, gbase, voff) do { _Pragma("unroll") for (int _i = 0; _i < 2; ++_i) \
        __builtin_amdgcn_global_load_lds((const unsigned*)((const char*)(gbase) + (voff)[_i]), (PG8_LAS unsigned*)(lds + (bufoff) + ldsw + _i * 8192), 16, 0, 0); } while (0)
#define PG8_LDA(dst, b, h) do { _Pragma("unroll") for (int m = 0; m < 4; ++m) _Pragma("unroll") for (int k = 0; k < 2; ++k) dst[m][k] = *(const PG8_LAS bf16x8*)(lds + PG8_SA(b, h) + aoff + m * 2048 + k * 1024); } while (0)
#define PG8_LDB(dst, b, h) do { _Pragma("unroll") for (int n = 0; n < 2; ++n) _Pragma("unroll") for (int k = 0; k < 2; ++k) dst[n][k] = *(const PG8_LAS bf16x8*)(lds + PG8_SB(b, h) + boff + n * 2048 + k * 1024); } while (0)
#define PG8_MMA(ai, bj, At, Bt) do { __builtin_amdgcn_s_setprio(1); _Pragma("unroll") for (int m = 0; m < 4; ++m) _Pragma("unroll") for (int n = 0; n < 2; ++n) _Pragma("unroll") for (int k = 0; k < 2; ++k) \
        acc[ai][bj][m][n] = __builtin_amdgcn_mfma_f32_16x16x32_bf16(Bt[n][k], At[m][k], acc[ai][bj][m][n], 0, 0, 0); __builtin_amdgcn_s_setprio(0); } while (0)
#define PG8_WAIT_V(n) asm volatile("s_waitcnt vmcnt(" #n ")" ::: "memory")
#define PG8_WAIT_L(n) asm volatile("s_waitcnt lgkmcnt(" #n ")" ::: "memory")
#define PG8_BAR __builtin_amdgcn_s_barrier()
#define PG8_SCHED __builtin_amdgcn_sched_barrier(0)
    Unit cur, nxt; int ui = 0;
    if (!S.next(0, cur)) return;
    f32x4 acc[2][2][4][2];
#pragma unroll
    for (int a = 0; a < 2; ++a)
#pragma unroll
        for (int b = 0; b < 2; ++b)
#pragma unroll
            for (int m = 0; m < 4; ++m)
#pragma unroll
                for (int n = 0; n < 2; ++n) acc[a][b][m][n] = (f32x4){0.f, 0.f, 0.f, 0.f};
    bf16x8 At[4][2], B0[2][2], B1[2][2];
#define PG8_UA(u) ((const char*)((TwoSeg<Epi>::v && (u).seg == 0) ? g.A0 : g.A) + (size_t)(u).pm * tstep)
#define PG8_UB(u) ((const char*)((TwoSeg<Epi>::v && (u).seg == 0) ? g.Bt0 : g.Bt) + (size_t)(u).pn * tstep)
    const char* cA = PG8_UA(cur); const char* cB = PG8_UB(cur);
    S.a_ready(cur);
    if constexpr (SP2) {
        PG8_STAGE(PG8_SB(0, 0), cB, voffB); PG8_STAGE(PG8_SB(0, 1), cB + hstep, voffB); PG8_STAGE(PG8_SA(0, 0), cA, voffA); PG8_STAGE(PG8_SA(0, 1), cA + hstep, voffA);
        if (wr == 1) PG8_BAR;
        PG8_WAIT_V(2); PG8_BAR;
        PG8_STAGE(PG8_SB(1, 0), cB + kstep, voffB); PG8_STAGE(PG8_SA(1, 0), cA + kstep, voffA); PG8_STAGE(PG8_SB(1, 1), cB + hstep + kstep, voffB);
        PG8_WAIT_V(6); PG8_BAR;
    } else {
        PG8_STAGE(PG8_SB(0, 0), cB, voffB); PG8_STAGE(PG8_SA(0, 0), cA, voffA); PG8_STAGE(PG8_SB(0, 1), cB + hstep, voffB); PG8_STAGE(PG8_SA(0, 1), cA + hstep, voffA);
        if (wr == 1) PG8_BAR;
        PG8_WAIT_V(4); PG8_BAR;
        PG8_STAGE(PG8_SB(1, 0), cB + kstep, voffB); PG8_STAGE(PG8_SA(1, 0), cA + kstep, voffA); PG8_STAGE(PG8_SB(1, 1), cB + hstep + kstep, voffB);
        PG8_WAIT_V(6); PG8_BAR;
    }
    for (;;) {
        const bool has_next = S.next(ui + 1, nxt);
        const char* nA = has_next ? PG8_UA(nxt) : cA; const char* nB = has_next ? PG8_UB(nxt) : cB;
        const int nt = (TwoSeg<Epi>::v && cur.seg == 0) ? nt0 : nt1;
        for (int t = 0; t < nt; t += 2) {
            const bool last = (t == nt - 2);
            const char* a1 = cA + (size_t)(t + 1) * kstep;
            const char* a2 = last ? nA : cA + (size_t)(t + 2) * kstep; const char* b2 = last ? nB : cB + (size_t)(t + 2) * kstep;
            const char* a3 = a2 + kstep; const char* b3 = b2 + kstep;
            if (last && has_next) S.a_ready(nxt);
            if constexpr (SP2) {
            PG8_LDB(B0, 0, 0); PG8_LDB(B1, 0, 1); PG8_SCHED; PG8_LDA(At, 0, 0); PG8_STAGE(PG8_SA(1, 1), a1 + hstep, voffA);
            PG8_WAIT_V(8); PG8_WAIT_L(0); PG8_BAR; PG8_MMA(0, 0, At, B0); PG8_MMA(0, 1, At, B1); PG8_BAR; PG8_SCHED;
            PG8_LDA(At, 0, 1); PG8_STAGE(PG8_SB(0, 0), b2, voffB); PG8_STAGE(PG8_SB(0, 1), b2 + hstep, voffB); PG8_STAGE(PG8_SA(0, 0), a2, voffA);
            PG8_WAIT_V(8); PG8_WAIT_L(0); PG8_BAR; PG8_MMA(1, 0, At, B0); PG8_MMA(1, 1, At, B1); PG8_BAR; PG8_SCHED;
            PG8_LDB(B0, 1, 0); PG8_LDB(B1, 1, 1); PG8_SCHED; PG8_LDA(At, 1, 0); PG8_STAGE(PG8_SA(0, 1), a2 + hstep, voffA);
            PG8_WAIT_V(8); PG8_WAIT_L(0); PG8_BAR; PG8_MMA(0, 0, At, B0); PG8_MMA(0, 1, At, B1); PG8_BAR; PG8_SCHED;
            PG8_LDA(At, 1, 1); PG8_STAGE(PG8_SB(1, 0), b3, voffB); PG8_STAGE(PG8_SB(1, 1), b3 + hstep, voffB); PG8_STAGE(PG8_SA(1, 0), a3, voffA);
            PG8_WAIT_V(8); PG8_WAIT_L(0); PG8_BAR; PG8_MMA(1, 0, At, B0); PG8_MMA(1, 1, At, B1); PG8_BAR; PG8_SCHED;
            } else {
            PG8_LDB(B0, 0, 0); PG8_SCHED; PG8_LDA(At, 0, 0); PG8_STAGE(PG8_SA(1, 1), a1 + hstep, voffA);
            PG8_WAIT_L(8); PG8_BAR; PG8_WAIT_L(0); PG8_MMA(0, 0, At, B0); PG8_BAR; PG8_SCHED;
            PG8_LDB(B1, 0, 1); PG8_STAGE(PG8_SB(0, 0), b2, voffB);
            PG8_BAR; PG8_WAIT_L(0); PG8_MMA(0, 1, At, B1); PG8_BAR;
            PG8_LDA(At, 0, 1); PG8_STAGE(PG8_SA(0, 0), a2, voffA);
            PG8_BAR; PG8_WAIT_L(0); PG8_MMA(1, 0, At, B0); PG8_BAR; PG8_SCHED;
            PG8_STAGE(PG8_SB(0, 1), b2 + hstep, voffB);
            PG8_WAIT_V(6); PG8_BAR; PG8_MMA(1, 1, At, B1); PG8_BAR;
            PG8_LDB(B0, 1, 0); PG8_SCHED; PG8_LDA(At, 1, 0); PG8_STAGE(PG8_SA(0, 1), a2 + hstep, voffA);
            PG8_WAIT_L(8); PG8_BAR; PG8_WAIT_L(0); PG8_MMA(0, 0, At, B0); PG8_BAR; PG8_SCHED;
            PG8_LDB(B1, 1, 1); PG8_STAGE(PG8_SB(1, 0), b3, voffB);
            PG8_BAR; PG8_WAIT_L(0); PG8_MMA(0, 1, At, B1); PG8_BAR;
            PG8_LDA(At, 1, 1); PG8_STAGE(PG8_SA(1, 0), a3, voffA);
            PG8_BAR; PG8_WAIT_L(0); PG8_MMA(1, 0, At, B0); PG8_BAR; PG8_SCHED;
            PG8_STAGE(PG8_SB(1, 1), b3 + hstep, voffB);
            PG8_WAIT_V(6); PG8_BAR; PG8_MMA(1, 1, At, B1); PG8_BAR;
            }
        }
        if constexpr (ALIGN_EPI) { if (wr == 0) PG8_BAR; }
        if constexpr (!Epi::AFTER_DRAIN) { E(acc, cur, wr, wc, fr, fq); S.done(cur); }
        if (!has_next) break;
        if (!(TwoSeg<Epi>::v && cur.seg == 0)) {
#pragma unroll
        for (int a = 0; a < 2; ++a)
#pragma unroll
            for (int b = 0; b < 2; ++b)
#pragma unroll
                for (int m = 0; m < 4; ++m)
#pragma unroll
                    for (int n = 0; n < 2; ++n) acc[a][b][m][n] = (f32x4){0.f, 0.f, 0.f, 0.f};
        }
        cur = nxt; cA = nA; cB = nB; ++ui;
        if constexpr (ALIGN_EPI) { if (wr == 1) PG8_BAR; }
    }
    PG8_WAIT_V(0);
    if constexpr (!ALIGN_EPI) { if (wr == 0) PG8_BAR; }
    PG8_BAR;
    if constexpr (Epi::AFTER_DRAIN) { E.fused(acc, cur, wr, wc, fr, fq, lds, wid, lane); S.done(cur); }
#undef PG8_UA
#undef PG8_UB
#undef PG8_SA
#undef PG8_SB
#undef PG8_STAGE
#undef PG8_LDA
#undef PG8_LDB
#undef PG8_MMA
#undef PG8_WAIT_V
#undef PG8_WAIT_L
#undef PG8_BAR
#undef PG8_SCHED
}
}

#define ACC8(v, ai, bj, m) const float v[8] = {acc[ai][bj][m][0][0], acc[ai][bj][m][0][1], acc[ai][bj][m][0][2], acc[ai][bj][m][0][3], acc[ai][bj][m][1][0], acc[ai][bj][m][1][1], acc[ai][bj][m][1][2], acc[ai][bj][m][1][3]}
template <class E8> struct EpiWrap {
    static constexpr bool PERM = true, AFTER_DRAIN = false;
    E8 e;
    __device__ __forceinline__ void operator()(const pg8::f32x4 (&acc)[2][2][4][2], const pg8::Unit& u, int wr, int wc, int fr, int fq) const {
#pragma unroll
        for (int ai = 0; ai < 2; ++ai)
#pragma unroll
            for (int m = 0; m < 4; ++m)
#pragma unroll
                for (int bj = 0; bj < 2; ++bj) { ACC8(v, ai, bj, m); e(u.pm * 256 + ai * 128 + wr * 64 + m * 16 + fr, u.pn * 256 + bj * 128 + wc * 32 + 8 * fq, v); }
    }
};
struct SegOrder : pg8::StaticOrder {
    __device__ __forceinline__ bool next(int i, pg8::Unit& u) const { if (!pg8::StaticOrder::next(i >> 1, u)) return false; u.seg = i & 1; return true; }
};
struct EpiMerge {
    static constexpr bool PERM = true, AFTER_DRAIN = false;
    bf16_t* U; const bf16_t* GATES;
    __device__ __forceinline__ void operator()(pg8::f32x4 (&acc)[2][2][4][2], const pg8::Unit& u, int wr, int wc, int fr, int fq) const {
#pragma unroll
        for (int ai = 0; ai < 2; ++ai)
#pragma unroll
            for (int m = 0; m < 4; ++m)
#pragma unroll
                for (int bj = 0; bj < 2; ++bj) {
                    const int row = u.pm * 256 + ai * 128 + wr * 64 + m * 16 + fr, c0 = u.pn * 256 + bj * 128 + wc * 32 + 8 * fq;
                    if (u.seg == 0) { float rr[8]; unpack8(__builtin_nontemporal_load((const u32x4*)(GATES + (size_t)row * 2048 + 1024 + c0)), rr);
#pragma unroll
                        for (int i = 0; i < 8; ++i) acc[ai][bj][m][i >> 2][i & 3] *= rr[i];
                    } else { float ga[8], o[8]; unpack8(__builtin_nontemporal_load((const u32x4*)(GATES + (size_t)row * 2048 + c0)), ga);
#pragma unroll
                        for (int i = 0; i < 8; ++i) o[i] = ga[i] * acc[ai][bj][m][i >> 2][i & 3];
                        *(u32x4*)(U + (size_t)row * DM + c0) = pack8(o); }
                }
    }
};
namespace pg8 { template <> struct TwoSeg<EpiMerge> { static constexpr bool v = true; }; }
struct EpiOutF {
    static constexpr bool PERM = true, AFTER_DRAIN = false;
    EpiOut e; float* SSQ; LAS float* xb;
    __device__ __forceinline__ void operator()(const pg8::f32x4 (&acc)[2][2][4][2], const pg8::Unit& u, int wr, int wc, int fr, int fq) const {
        LAS char* xl = (LAS char*)xb + ((wr * 64 + fr) * 8 + wc) * 4; asm volatile("" : "+v"(xl));
        const int b = u.pm >> 4; const float* mb = e.mod + (size_t)b * NMOD;
#pragma unroll
        for (int bj = 0; bj < 2; ++bj) {
            const int c0 = u.pn * 256 + bj * 128 + wc * 32 + 8 * fq; float g1[8], gm[8];
#pragma unroll
            for (int h = 0; h < 2; ++h) { const f32x4 a = *(const f32x4*)(mb + 2 * DM + c0 + 4 * h), sc = *(const f32x4*)(mb + 4 * DM + c0 + 4 * h), ng = *(const f32x4*)(e.n2g + c0 + 4 * h);
#pragma unroll
                for (int i = 0; i < 4; ++i) { g1[4 * h + i] = a[i]; gm[4 * h + i] = ng[i] * (1.0f + sc[i]); } }
#pragma unroll
            for (int ai = 0; ai < 2; ++ai) {
                f32x4 xa[4], xc[4];
#pragma unroll
                for (int m = 0; m < 4; ++m) { const size_t off = (size_t)(u.pm * 256 + ai * 128 + wr * 64 + m * 16 + fr) * DM + c0; xa[m] = __builtin_nontemporal_load((const f32x4*)(e.x + off)); xc[m] = __builtin_nontemporal_load((const f32x4*)(e.x + off + 4)); }
#pragma unroll
                for (int m = 0; m < 4; ++m) { ACC8(v, ai, bj, m); const size_t off = (size_t)(u.pm * 256 + ai * 128 + wr * 64 + m * 16 + fr) * DM + c0;
                    float o[8], y[8], s = 0.f;
#pragma unroll
                    for (int i = 0; i < 8; ++i) { o[i] = (i < 4 ? xa[m][i & 3] : xc[m][i & 3]) + g1[i] * v[i]; s += o[i] * o[i]; y[i] = o[i] * gm[i]; }
                    *(f32x4*)(e.out + off) = (f32x4){o[0], o[1], o[2], o[3]}; *(f32x4*)(e.out + off + 4) = (f32x4){o[4], o[5], o[6], o[7]};
                    *(u32x4*)(e.Y2 + off) = pack8(y);
                    s += __shfl_xor(s, 16); s += __shfl_xor(s, 32);
                    if (fq == 0) *(LAS float*)(xl + ((ai * 128 + m * 16) * 8 + bj * 4) * 4) = s; }
                asm volatile("" ::: "memory");
            }
        }
        LDS_WAIT(); __builtin_amdgcn_s_barrier(); asm volatile("" ::: "memory");
        const int t = threadIdx.x;
        if (t < 256) { LAS char* xr = (LAS char*)xb + t * 32; asm volatile("" : "+v"(xr)); const f32x4 a = *(const LAS f32x4*)xr, b2 = *(const LAS f32x4*)(xr + 16);
            SSQ[(size_t)(u.pm * 256 + t) * 4 + u.pn] = ((a[0] + a[1]) + (a[2] + a[3])) + ((b2[0] + b2[1]) + (b2[2] + b2[3])); }
    }
};
struct EpiUpF {
    static constexpr bool PERM = true, AFTER_DRAIN = false;
    EpiUp e; const float* SSQ;
    __device__ __forceinline__ void operator()(const pg8::f32x4 (&acc)[2][2][4][2], const pg8::Unit& u, int wr, int wc, int fr, int fq) const {
        const int b = u.pm >> 4, c0 = u.pn * 128 + wc * 32 + 8 * fq; const float* bb = e.bias2 + (size_t)b * NUP + u.pn * 256 + wc * 32 + 8 * fq; float ba[8], bg[8];
#pragma unroll
        for (int h = 0; h < 2; ++h) { const f32x4 a = *(const f32x4*)(bb + 4 * h), g = *(const f32x4*)(bb + 128 + 4 * h);
#pragma unroll
            for (int i = 0; i < 4; ++i) { ba[4 * h + i] = a[i]; bg[4 * h + i] = g[i]; } }
#pragma unroll
        for (int ai = 0; ai < 2; ++ai)
#pragma unroll
            for (int m = 0; m < 4; ++m) { ACC8(va, ai, 0, m); ACC8(vb, ai, 1, m); const int row = u.pm * 256 + ai * 128 + wr * 64 + m * 16 + fr; const float rstd = row_rstd(SSQ, row); float o[8];
#pragma unroll
                for (int i = 0; i < 8; ++i) o[i] = siluf_(rstd * va[i] + ba[i]) * (rstd * vb[i] + bg[i]);
                *(u32x4*)(e.ACT + (size_t)row * FF + c0) = pack8(o); }
    }
};
struct EpiDownF {
    static constexpr bool PERM = true, AFTER_DRAIN = false;
    EpiDown e;
    __device__ __forceinline__ void operator()(const pg8::f32x4 (&acc)[2][2][4][2], const pg8::Unit& u, int wr, int wc, int fr, int fq) const {
        const int b = u.pm >> 4;
#pragma unroll
        for (int bj = 0; bj < 2; ++bj) { const int c0 = u.pn * 256 + bj * 128 + wc * 32 + 8 * fq; const float* g2p = e.mod + (size_t)b * NMOD + 5 * DM + c0; const f32x4 ga = *(const f32x4*)g2p, gb = *(const f32x4*)(g2p + 4);
#pragma unroll
            for (int ai = 0; ai < 2; ++ai)
#pragma unroll
                for (int m = 0; m < 4; ++m) { ACC8(v, ai, bj, m); const size_t off = (size_t)(u.pm * 256 + ai * 128 + wr * 64 + m * 16 + fr) * DM + c0;
                    f32x4 xa = __builtin_nontemporal_load((const f32x4*)(e.out + off)), xc = __builtin_nontemporal_load((const f32x4*)(e.out + off + 4));
#pragma unroll
                    for (int i = 0; i < 4; ++i) { xa[i] += ga[i] * v[i]; xc[i] += gb[i] * v[4 + i]; }
                    float* dst = e.dump ? e.dump + (off & (size_t)0x7ffff8) : e.out + off;
                    __builtin_nontemporal_store(xa, (f32x4*)dst); __builtin_nontemporal_store(xc, (f32x4*)(dst + 4)); }
        }
    }
};
template <bool CTXMODE> struct EpiInF {
    static constexpr bool PERM = true, AFTER_DRAIN = false;
    bf16_t *Q, *K, *Kc; const float *qg, *kg; EpiInRest rest; EpiCtxV cv; LAS float* xb;
    __device__ __forceinline__ void operator()(const pg8::f32x4 (&acc)[2][2][4][2], const pg8::Unit& u, int wr, int wc, int fr, int fq) const {
        const bool normed = CTXMODE ? (u.pn == 0) : (u.pn < 5);
        if (!normed) {
            if (CTXMODE) {
#pragma unroll
                for (int ai = 0; ai < 2; ++ai)
#pragma unroll
                    for (int m = 0; m < 4; ++m)
#pragma unroll
                        for (int bj = 0; bj < 2; ++bj) { ACC8(v, ai, bj, m); cv(u.pm * 256 + ai * 128 + wr * 64 + m * 16 + fr, bj * 128 + wc * 32 + 8 * fq, v); }
            } else if (u.pn < 8) {
#pragma unroll
                for (int ai = 0; ai < 2; ++ai)
#pragma unroll
                    for (int m = 0; m < 4; ++m)
#pragma unroll
                        for (int bj = 0; bj < 2; ++bj) { ACC8(v, ai, bj, m); rest(u.pm * 256 + ai * 128 + wr * 64 + m * 16 + fr, u.pn * 256 + bj * 128 + wc * 32 + 8 * fq, v); }
            } else {
                const int c0 = (u.pn - 8) * 128 + wc * 32 + 8 * fq; float ba[8], bp[8];
#pragma unroll
                for (int h = 0; h < 2; ++h) { const f32x4 a = *(const f32x4*)(rest.gate_b + c0 + 4 * h), p = *(const f32x4*)(rest.gate_b + 1024 + c0 + 4 * h);
#pragma unroll
                    for (int i = 0; i < 4; ++i) { ba[4 * h + i] = a[i]; bp[4 * h + i] = p[i]; } }
#pragma unroll
                for (int ai = 0; ai < 2; ++ai)
#pragma unroll
                    for (int m = 0; m < 4; ++m) { ACC8(va, ai, 0, m); ACC8(vp, ai, 1, m); float oa[8], orr[8];
#pragma unroll
                        for (int i = 0; i < 8; ++i) { const float ea = fminf(1.0f + __builtin_amdgcn_exp2f(-LOG2E * (va[i] + ba[i])), 1e30f), ep = 1.0f + __builtin_amdgcn_exp2f(-LOG2E * (vp[i] + bp[i]));
                            oa[i] = __builtin_amdgcn_rcpf(ea); orr[i] = ea * __builtin_amdgcn_rcpf(ep); }
                        bf16_t* gp_ = rest.GATES + (size_t)(u.pm * 256 + ai * 128 + wr * 64 + m * 16 + fr) * 2048 + c0;
                        *(u32x4*)gp_ = pack8(oa); *(u32x4*)(gp_ + 1024) = pack8(orr); }
            }
            return;
        }
        const bool isq = u.pn < 4; const float* g = isq ? qg : kg;
        float g1[2][4], g2[2][4];
#pragma unroll
        for (int bj = 0; bj < 2; ++bj) { const f32x4 a1 = *(const f32x4*)(g + 32 * bj + 4 * fq), a2 = *(const f32x4*)(g + 32 * bj + 16 + 4 * fq);
#pragma unroll
            for (int i = 0; i < 4; ++i) { g1[bj][i] = a1[i]; g2[bj][i] = a2[i]; } }
        const LAS float* tab = xb + 2048 + 4 * fq; asm volatile("" : "+v"(tab));
        bf16_t* dbase = isq ? Q + (size_t)(u.pn * 4 + wc) * 64 + 4 * fq : K + (size_t)wc * 64 + 4 * fq; const int dpitch = isq ? DM : KVW;
#pragma unroll
        for (int ai = 0; ai < 2; ++ai)
#pragma unroll
            for (int m = 0; m < 4; ++m) {
                const int row = u.pm * 256 + ai * 128 + wr * 64 + m * 16 + fr, t = row & 4095;
                float s = 0.f;
#pragma unroll
                for (int bj = 0; bj < 2; ++bj) { ACC8(v, ai, bj, m);
#pragma unroll
                    for (int i = 0; i < 8; ++i) s += v[i] * v[i]; }
                s += __shfl_xor(s, 16); s += __shfl_xor(s, 32);
                const float rstd = __builtin_amdgcn_rsqf(s * (1.0f / 64.0f) + EPS) * (isq ? QSCALE : 1.0f);
#pragma unroll
                for (int bj = 0; bj < 2; ++bj) { ACC8(v, ai, bj, m); const int pos = bj ? (t & 63) : (t >> 6);
                    const f32x4 cs = *(const LAS f32x4*)(tab + pos * 16), sn = *(const LAS f32x4*)(tab + 1024 + pos * 16); float o1[4], o2[4];
#pragma unroll
                    for (int i = 0; i < 4; ++i) { const float x1 = v[i] * rstd * g1[bj][i], x2 = v[4 + i] * rstd * g2[bj][i]; o1[i] = x1 * cs[i] - x2 * sn[i]; o2[i] = x2 * cs[i] + x1 * sn[i]; }
                    bf16_t* dst = dbase + (size_t)row * dpitch + 32 * bj; u32x2 w1, w2;
                    w1.x = cvtpk(o1[0], o1[1]); w1.y = cvtpk(o1[2], o1[3]); w2.x = cvtpk(o2[0], o2[1]); w2.y = cvtpk(o2[2], o2[3]);
                    const auto sx = __builtin_amdgcn_permlane16_swap(w1.x, w2.x, false, false), sy = __builtin_amdgcn_permlane16_swap(w1.y, w2.y, false, false);
                    u32x4 w; w.x = sx[0]; w.y = sy[0]; w.z = sx[1]; w.w = sy[1];
                    *(u32x4*)(dst + ((fq & 1) ? 12 : 0)) = w; }
            }
    }
};

typedef short bf16x8_t __attribute__((ext_vector_type(8)));
typedef float f32x16 __attribute__((ext_vector_type(16)));
__device__ __forceinline__ int crow(int reg, int h) { return (reg & 3) + 8 * (reg >> 2) + 4 * h; }
#define MFMA32(a, b, c) __builtin_amdgcn_mfma_f32_32x32x16_bf16((a), (b), (c), 0, 0, 0)
constexpr int AT_KP = 144, AT_VP = 272, AT_KB = 128 * AT_KP, AT_VB = 64 * AT_VP;
constexpr int AT_BUF = AT_KB + AT_VB;
constexpr int AT_K0 = 0, AT_V0 = 2 * AT_KB;

__device__ __forceinline__ bool attn_unit(const Ptrs& P, LAS unsigned char* lds, int unit, int tid, int wave, int lane, bool pre, int nxt) {
    const int n = unit & 31, kh = (unit >> 5) & 3, b = unit >> 7;
    const int g = wave & 3, q0 = 64 * (wave >> 2), h = kh * 4 + g, r = lane & 31, hh = lane >> 5;
    unsigned char* ws = P.ws;
    bf16_t* Qb = (bf16_t*)(ws + WS_Q) + (size_t)(b * SEQ + n * 128 + q0) * DM + h * 64;
    const bf16_t* Kg = (const bf16_t*)(ws + WS_K) + (size_t)b * SEQ * KVW + kh * 64; const bf16_t* Vg = (const bf16_t*)(ws + WS_VT) + (size_t)(b * 4 + kh) * 64 * SEQ;
    const bf16_t* Kcg = (const bf16_t*)(ws + WS_KC) + (size_t)b * CTX * KVW + kh * 64; const bf16_t* Vcg = (const bf16_t*)(ws + WS_VCT) + (size_t)(b * 4 + kh) * 64 * CTX;
    float mq = fabsf(P.qg[lane]), mk = fabsf(P.kg[lane]);
#pragma unroll
    for (int o = 1; o < 64; o <<= 1) { mq = fmaxf(mq, __shfl_xor(mq, o)); mk = fmaxf(mk, __shfl_xor(mk, o)); }
    const float sink2 = P.sink[h] * LOG2E; const float mshift = fmaxf(64.0f * QSCALE * mq * mk, sink2);
    bf16x8_t qf[2][4];
#pragma unroll
    for (int cb = 0; cb < 2; ++cb)
#pragma unroll
        for (int ds = 0; ds < 4; ++ds) qf[cb][ds] = __builtin_nontemporal_load((const bf16x8_t*)(Qb + (size_t)(32 * cb + r) * DM + 16 * ds + 8 * hh));
    f32x16 o[2][2];
#pragma unroll
    for (int db = 0; db < 2; ++db)
#pragma unroll
        for (int cb = 0; cb < 2; ++cb)
#pragma unroll
            for (int i = 0; i < 16; ++i) o[db][cb][i] = 0.f;
    float rs[2] = {0.f, 0.f};
    f32x16 negm;
#pragma unroll
    for (int i = 0; i < 16; ++i) negm[i] = -mshift;
#define AT_DMA(c) do { const int b_ = (c) % 3; const bf16_t* kb_ = (c) < 3 ? Kg + (size_t)(n - 1 + (c)) * 128 * KVW : Kcg + (size_t)((c) - 3) * 128 * KVW; \
        const bf16_t* vb_ = (c) < 3 ? Vg + (n - 1 + (c)) * 128 : Vcg + ((c) - 3) * 128; const int vp_ = (c) < 3 ? SEQ : CTX; \
        for (int i_ = wave; i_ < 35; i_ += 8) { \
            if (i_ < 18) { const int q_ = 64 * i_ + lane, row_ = q_ / 9; int seg_ = q_ - 9 * row_; seg_ = seg_ == 8 ? 0 : seg_; \
                __builtin_amdgcn_global_load_lds((const unsigned*)(kb_ + (size_t)row_ * KVW + seg_ * 8), (LAS unsigned*)(lds + b_ * AT_BUF + i_ * 1024), 16, 0, 0); } \
            else { const int q_ = 64 * (i_ - 18) + lane, row_ = q_ / 17; int seg_ = q_ - 17 * row_; seg_ = seg_ == 16 ? 0 : seg_; \
                __builtin_amdgcn_global_load_lds((const unsigned*)(vb_ + (size_t)row_ * vp_ + seg_ * 8), (LAS unsigned*)(lds + b_ * AT_BUF + AT_KB + (i_ - 18) * 1024), 16, 0, 0); } } } while (0)
#define AT_SYNC() do { asm volatile("s_waitcnt vmcnt(0) lgkmcnt(0)" ::: "memory"); __builtin_amdgcn_s_barrier(); asm volatile("" ::: "memory"); } while (0)
    if (!pre) { if (n == 0) AT_DMA(1); else AT_DMA(0); }
    AT_SYNC();
    const int n2 = nxt & 31; const bool pf = nxt >= 0 && n2 != 0;
#pragma unroll
    for (int c = 0; c < 5; ++c) {
        if (c == 0 && n == 0) continue;
        if (c == 2 && n == 31) continue;
        if (c == 0) AT_DMA(1);
        if (c == 1) { if (n == 31) AT_DMA(3); else AT_DMA(2); }
        if (c == 2) AT_DMA(3);
        if (c == 3) AT_DMA(4);
        if (c == 4 && pf) { const int kh2 = (nxt >> 5) & 3, b2 = nxt >> 7; const bf16_t* kb_ = (const bf16_t*)(ws + WS_K) + (size_t)b2 * SEQ * KVW + kh2 * 64 + (size_t)(n2 - 1) * 128 * KVW; const bf16_t* vb_ = (const bf16_t*)(ws + WS_VT) + (size_t)(b2 * 4 + kh2) * 64 * SEQ + (n2 - 1) * 128;
            for (int i_ = wave; i_ < 35; i_ += 8) {
                if (i_ < 18) { const int q_ = 64 * i_ + lane, row_ = q_ / 9; int seg_ = q_ - 9 * row_; seg_ = seg_ == 8 ? 0 : seg_;
                    __builtin_amdgcn_global_load_lds((const unsigned*)(kb_ + (size_t)row_ * KVW + seg_ * 8), (LAS unsigned*)(lds + i_ * 1024), 16, 0, 0); }
                else { const int q_ = 64 * (i_ - 18) + lane, row_ = q_ / 17; int seg_ = q_ - 17 * row_; seg_ = seg_ == 16 ? 0 : seg_;
                    __builtin_amdgcn_global_load_lds((const unsigned*)(vb_ + (size_t)row_ * SEQ + seg_ * 8), (LAS unsigned*)(lds + AT_KB + (i_ - 18) * 1024), 16, 0, 0); } } }
        const LAS unsigned char* Kl = lds + (c % 3) * AT_BUF; const LAS unsigned char* Vl = Kl + AT_KB;
#pragma unroll 1
        for (int kt = 0; kt < 4; ++kt) {
            if (c == 0 && 32 * kt + 31 < q0) continue;
            if (c == 2 && 32 * kt > q0 + 63) continue;
            bf16x8_t kf[4], vf[2][2];
#pragma unroll
            for (int ds = 0; ds < 4; ++ds) kf[ds] = *(const LAS bf16x8_t*)(Kl + (32 * kt + r) * AT_KP + (16 * ds + 8 * hh) * 2);
#pragma unroll
            for (int db = 0; db < 2; ++db)
#pragma unroll
                for (int s = 0; s < 2; ++s) vf[db][s] = *(const LAS bf16x8_t*)(Vl + (32 * db + r) * AT_VP + (32 * kt + 16 * s + 8 * hh) * 2);
#pragma unroll
            for (int cb = 0; cb < 2; ++cb) {
                const int dq = 32 * kt - (q0 + 32 * cb);
                if ((c == 0 && dq < 0) || (c == 2 && dq > 0)) continue;
                const bool diag = (c == 0 || c == 2) && dq == 0;
                f32x16 st = MFMA32(kf[0], qf[cb][0], negm);
                st = MFMA32(kf[1], qf[cb][1], st); st = MFMA32(kf[2], qf[cb][2], st); st = MFMA32(kf[3], qf[cb][3], st);
                float p[16];
#pragma unroll
                for (int i = 0; i < 16; ++i) p[i] = __builtin_amdgcn_exp2f(st[i]);
                if (diag) {
                    const int thr = r - 4 * hh;
#pragma unroll
                    for (int i = 0; i < 16; ++i) { const bool vis = c == 0 ? crow(i, 0) >= thr : crow(i, 0) <= thr; p[i] = vis ? p[i] : 0.f; }
                }
                float s4 = 0.f;
#pragma unroll
                for (int i = 0; i < 16; ++i) s4 += p[i];
                rs[cb] += s4;
#pragma unroll
                for (int s = 0; s < 2; ++s) {
                    u32x4 w; w.x = cvtpk(p[8 * s], p[8 * s + 1]); w.y = cvtpk(p[8 * s + 2], p[8 * s + 3]); w.z = cvtpk(p[8 * s + 4], p[8 * s + 5]); w.w = cvtpk(p[8 * s + 6], p[8 * s + 7]);
                    const bf16x8_t pb = __builtin_bit_cast(bf16x8_t, w);
                    o[0][cb] = MFMA32(vf[0][s], pb, o[0][cb]); o[1][cb] = MFMA32(vf[1][s], pb, o[1][cb]);
                }
            }
        }
        AT_SYNC();
    }
#undef AT_DMA
#undef AT_SYNC
    const float sk = __builtin_amdgcn_exp2f(sink2 - mshift);
#pragma unroll
    for (int cb = 0; cb < 2; ++cb) {
        const float den = rs[cb] + __shfl_xor(rs[cb], 32) + sk; const float inv = __builtin_amdgcn_rcpf(den);
        bf16_t* orow = (bf16_t*)(ws + WS_ATT) + (size_t)(b * SEQ + n * 128 + q0 + 32 * cb + r) * DM + h * 64;
#pragma unroll
        for (int db = 0; db < 2; ++db)
#pragma unroll
            for (int p = 0; p < 2; ++p) { u32x2 w0, w1;
                w0.x = cvtpk(o[db][cb][8 * p] * inv, o[db][cb][8 * p + 1] * inv); w0.y = cvtpk(o[db][cb][8 * p + 2] * inv, o[db][cb][8 * p + 3] * inv);
                w1.x = cvtpk(o[db][cb][8 * p + 4] * inv, o[db][cb][8 * p + 5] * inv); w1.y = cvtpk(o[db][cb][8 * p + 6] * inv, o[db][cb][8 * p + 7] * inv);
                const auto sx = __builtin_amdgcn_permlane32_swap(w0.x, w1.x, false, false), sy = __builtin_amdgcn_permlane32_swap(w0.y, w1.y, false, false);
                u32x4 w; w.x = sx[0]; w.y = sy[0]; w.z = sx[1]; w.w = sy[1];
                *(u32x4*)(orow + 32 * db + 8 * (2 * p + hh)) = w; }
    }
    return pf;
}

constexpr int PL_U = 0, PL_A = 144 * 256, PL_AP = 272;
__device__ __forceinline__ void pool_unit(const Ptrs& P, LAS unsigned char* lds, int unit, int tid, int wave, int lane) {
    const int g = unit & 3, tt = unit >> 2, ts0 = (tt & 31) * 128; unsigned char* ws = P.ws;
    const bf16_t* PI = (const bf16_t*)(ws + WS_POOLIN) + (size_t)tt * 128 * POOLW + g * 128;
    for (int p = tid; p < 144 * 16; p += NTHR) { const int rr = p >> 4, seg = p & 15, ts = ts0 - 8 + rr; u32x4 v = {0u, 0u, 0u, 0u};
        if (ts >= 0 && ts < SEQ) v = __builtin_nontemporal_load((const u32x4*)(PI + (ptrdiff_t)(rr - 8) * POOLW + seg * 8));
        *(LAS u32x4*)(lds + PL_U + rr * 256 + seg * 16) = v; }
    LDS_WAIT(); __builtin_amdgcn_s_barrier(); asm volatile("" ::: "memory");
    {
        const int c = tid & 127, tl0 = (tid >> 7) * 32, w2 = 1 << g; const LAS bf16_t* U = (const LAS bf16_t*)(lds + PL_U) + c; float sum = 0.f;
        for (int j = tl0 - w2; j < tl0 + w2; ++j) sum += bf2f(U[(j + 8) * 128]);
        for (int tl = tl0; tl < tl0 + 32; ++tl) {
            const int ts = ts0 + tl, lo = ts - w2 < 0 ? 0 : ts - w2, hi = ts + w2 > SEQ ? SEQ : ts + w2;
            const float d = sum * __builtin_amdgcn_rcpf((float)(hi - lo)) - bf2f(U[(tl + 8) * 128]);
            *(LAS bf16_t*)(lds + PL_A + tl * PL_AP + c * 2) = (bf16_t)(cvtpk(d, 0.f) & 0xffffu);
            sum += bf2f(U[(tl + w2 + 8) * 128]) - bf2f(U[(tl - w2 + 8) * 128]);
        }
    }
    LDS_WAIT(); __builtin_amdgcn_s_barrier(); asm volatile("" ::: "memory");
    {
        const int rb = wave >> 1, r = lane & 31, hh = lane >> 5; const bf16_t* PWg = (const bf16_t*)(ws + WS_PW) + g * 16384;
        f32x16 acc[2];
#pragma unroll
        for (int j = 0; j < 2; ++j)
#pragma unroll
            for (int i = 0; i < 16; ++i) acc[j][i] = 0.f;
        bf16x8_t wa[2][8];
#pragma unroll
        for (int j = 0; j < 2; ++j)
#pragma unroll
            for (int ks = 0; ks < 8; ++ks) wa[j][ks] = *(const bf16x8_t*)(PWg + (size_t)(32 * (2 * (wave & 1) + j) + r) * 128 + 16 * ks + 8 * hh);
#pragma unroll
        for (int ks = 0; ks < 8; ++ks) {
            const bf16x8_t bt = *(const LAS bf16x8_t*)(lds + PL_A + (32 * rb + r) * PL_AP + (16 * ks + 8 * hh) * 2);
#pragma unroll
            for (int j = 0; j < 2; ++j) acc[j] = MFMA32(wa[j][ks], bt, acc[j]);
        }
        bf16_t* PMr = (bf16_t*)(ws + WS_PM) + (size_t)(tt * 128 + 32 * rb + r) * PMP + g * 128;
#pragma unroll
        for (int j = 0; j < 2; ++j)
#pragma unroll
            for (int g4 = 0; g4 < 4; ++g4) { const int d = 32 * (2 * (wave & 1) + j) + 8 * g4 + 4 * hh; const f32x4 sc = *(const f32x4*)(P.pool_scale + g * 128 + d);
                u32x2 w; w.x = cvtpk(acc[j][4 * g4] * sc[0], acc[j][4 * g4 + 1] * sc[1]); w.y = cvtpk(acc[j][4 * g4 + 2] * sc[2], acc[j][4 * g4 + 3] * sc[3]);
                *(u32x2*)(PMr + d) = w; }
    }
    LDS_WAIT(); __builtin_amdgcn_s_barrier(); asm volatile("" ::: "memory");
}

__device__ __forceinline__ void pool_units(const Ptrs& P, LAS unsigned char* lds, int bx, int G, int tid, int wave, int lane) {
    unsigned char* ws = P.ws; const int NU = (MTOK / 128) * 4;
    int u = bx; if (u >= NU) return;
    u32x4 tv[5]; bf16x8_t wa[2][8]; int gcur = -1;
    const int r = lane & 31, hh = lane >> 5, rb = wave >> 1;
#define PL_LOAD(unit_) do { const int g_ = (unit_) & 3, tt_ = (unit_) >> 2, ts0_ = (tt_ & 31) * 128; const bf16_t* PI_ = (const bf16_t*)(ws + WS_POOLIN) + (size_t)tt_ * 128 * POOLW + g_ * 128; \
        _Pragma("unroll") for (int i_ = 0; i_ < 5; ++i_) { const int p_ = tid + NTHR * i_, rr_ = p_ >> 4, seg_ = p_ & 15, ts_ = ts0_ - 8 + rr_; tv[i_] = (u32x4){0u, 0u, 0u, 0u}; \
            if (p_ < 144 * 16 && ts_ >= 0 && ts_ < SEQ) tv[i_] = __builtin_nontemporal_load((const u32x4*)(PI_ + (ptrdiff_t)(rr_ - 8) * POOLW + seg_ * 8)); } } while (0)
    PL_LOAD(u);
    for (;;) {
        const int g = u & 3, tt = u >> 2, ts0 = (tt & 31) * 128;
#pragma unroll
        for (int i = 0; i < 5; ++i) { const int p = tid + NTHR * i; if (p < 144 * 16) *(LAS u32x4*)(lds + PL_U + (p >> 4) * 256 + (p & 15) * 16) = tv[i]; }
        if (g != gcur) { const bf16_t* PWg = (const bf16_t*)(ws + WS_PW) + g * 16384; gcur = g;
#pragma unroll
            for (int j = 0; j < 2; ++j)
#pragma unroll
                for (int ks = 0; ks < 8; ++ks) wa[j][ks] = *(const bf16x8_t*)(PWg + (size_t)(32 * (2 * (wave & 1) + j) + r) * 128 + 16 * ks + 8 * hh); }
        LDS_WAIT(); __builtin_amdgcn_s_barrier(); asm volatile("" ::: "memory");
        const int un = u + G; const bool hasn = un < NU;
        if (hasn) PL_LOAD(un);
        {
            const int c = tid & 127, tl0 = (tid >> 7) * 32, w2 = 1 << g; const LAS bf16_t* U = (const LAS bf16_t*)(lds + PL_U) + c; float sum = 0.f;
            for (int j = tl0 - w2; j < tl0 + w2; ++j) sum += bf2f(U[(j + 8) * 128]);
            for (int tl = tl0; tl < tl0 + 32; ++tl) {
                const int ts = ts0 + tl, lo = ts - w2 < 0 ? 0 : ts - w2, hi = ts + w2 > SEQ ? SEQ : ts + w2;
                const float d = sum * __builtin_amdgcn_rcpf((float)(hi - lo)) - bf2f(U[(tl + 8) * 128]);
                *(LAS bf16_t*)(lds + PL_A + tl * PL_AP + c * 2) = (bf16_t)(cvtpk(d, 0.f) & 0xffffu);
                sum += bf2f(U[(tl + w2 + 8) * 128]) - bf2f(U[(tl - w2 + 8) * 128]);
            }
        }
        LDS_WAIT(); __builtin_amdgcn_s_barrier(); asm volatile("" ::: "memory");
        {
            f32x16 acc[2];
#pragma unroll
            for (int j = 0; j < 2; ++j)
#pragma unroll
                for (int i = 0; i < 16; ++i) acc[j][i] = 0.f;
#pragma unroll
            for (int ks = 0; ks < 8; ++ks) {
                const bf16x8_t bt = *(const LAS bf16x8_t*)(lds + PL_A + (32 * rb + r) * PL_AP + (16 * ks + 8 * hh) * 2);
#pragma unroll
                for (int j = 0; j < 2; ++j) acc[j] = MFMA32(wa[j][ks], bt, acc[j]);
            }
            bf16_t* PMr = (bf16_t*)(ws + WS_PM) + (size_t)(tt * 128 + 32 * rb + r) * PMP + g * 128;
#pragma unroll
            for (int j = 0; j < 2; ++j)
#pragma unroll
                for (int g4 = 0; g4 < 4; ++g4) { const int d = 32 * (2 * (wave & 1) + j) + 8 * g4 + 4 * hh; const f32x4 sc = *(const f32x4*)(P.pool_scale + g * 128 + d);
                    u32x2 w; w.x = cvtpk(acc[j][4 * g4] * sc[0], acc[j][4 * g4 + 1] * sc[1]); w.y = cvtpk(acc[j][4 * g4 + 2] * sc[2], acc[j][4 * g4 + 3] * sc[3]);
                    *(u32x2*)(PMr + d) = w; }
        }
        LDS_WAIT(); __builtin_amdgcn_s_barrier(); asm volatile("" ::: "memory");
        if (!hasn) break;
        u = un;
    }
#undef PL_LOAD
}

typedef __attribute__((address_space(1))) unsigned gu32;
#define XB_TMO      128
#define XB_XCNT(j)  (256  + 64 * (j))
#define XB_XSUB(j)  (1280 + 64 * (j))
#define XB_XGEN(j)  (2304 + 64 * (j))
#define XB_TOP      3328
#define XB_TOPGEN   3392
#define XCD_BAR_WORDS 3456
#define XB_SPIN_CAP (1u << 18)

__device__ __forceinline__ unsigned xb_ld(unsigned* p)              { return __hip_atomic_load(p, __ATOMIC_RELAXED, __HIP_MEMORY_SCOPE_AGENT); }
__device__ __forceinline__ unsigned xb_add(unsigned* p, unsigned v) { return __hip_atomic_fetch_add(p, v, __ATOMIC_RELAXED, __HIP_MEMORY_SCOPE_AGENT); }
__device__ __forceinline__ unsigned xb_xcc_id() { return (unsigned)__builtin_amdgcn_s_getreg((3 << 11) | 20) & 0xFu; }
#define XB_SPIN(cond, bar) do { unsigned _sp = 0; while (cond) { __builtin_amdgcn_s_sleep(1); \
    if ((++_sp & 255u) == 0u) { if (xb_ld(&(bar)[XB_TMO])) break; if (_sp > XB_SPIN_CAP) { atomicAdd(&(bar)[XB_TMO], 1u); break; } } } } while (0)

struct XcdBarrier {
    unsigned* bar; unsigned x;
    volatile LAS unsigned* st;
};

__device__ __forceinline__ XcdBarrier xcd_barrier_post(unsigned* bar, volatile LAS unsigned* st) {
    XcdBarrier b; b.bar = bar; b.x = xb_xcc_id(); b.st = st;
    if (threadIdx.x == 0) (void)xb_add(&bar[XB_XCNT(b.x)], 1u);
    return b;
}
__device__ __forceinline__ void xcd_barrier_complete(unsigned* bar, unsigned x, unsigned& nloc, unsigned& nx) {
    const unsigned G = gridDim.x * gridDim.y * gridDim.z;
    unsigned sum, cnt, mine, sp = 0u;
    for (;;) {
        sum = 0u; cnt = 0u; mine = 0u;
#pragma unroll
        for (unsigned j = 0; j < 16; ++j) { const unsigned c = xb_ld(&bar[XB_XCNT(j)]); sum += c; cnt += (c > 0u) ? 1u : 0u; mine = (j == x) ? c : mine; }
        if (sum == G) break;
        __builtin_amdgcn_s_sleep(1);
        if ((++sp & 255u) == 0u) { if (xb_ld(&bar[XB_TMO])) break; if (sp > XB_SPIN_CAP) { atomicAdd(&bar[XB_TMO], 1u); break; } }
    }
    nloc = mine > 0u ? mine : 1u; nx = cnt > 0u ? cnt : 1u;
}

__device__ __forceinline__ void xcd_barrier(const XcdBarrier& b) {
    asm volatile("s_waitcnt vmcnt(0)" ::: "memory");
    __syncthreads();
    if (threadIdx.x == 0) {
        unsigned* bar = b.bar;
        __builtin_amdgcn_s_waitcnt(0);
        unsigned nloc = b.st[0], nx = b.st[1];
        if (nloc == 0u) { xcd_barrier_complete(bar, b.x, nloc, nx); b.st[0] = nloc; b.st[1] = nx; }
        const unsigned old = xb_add(&bar[XB_XSUB(b.x)], 1u);
        const unsigned gen = old / nloc;
        if (old + 1u == (gen + 1u) * nloc) {
            __builtin_amdgcn_fence(__ATOMIC_RELEASE, "agent");
            asm volatile("s_waitcnt vmcnt(0)" ::: "memory");
            const unsigned og = xb_add(&bar[XB_TOP], 1u);
            const unsigned tg = og / nx;
            if (og + 1u == (tg + 1u) * nx) xb_add(&bar[XB_TOPGEN], 1u);
            else XB_SPIN(xb_ld(&bar[XB_TOPGEN]) == tg, bar);
            __builtin_amdgcn_fence(__ATOMIC_ACQUIRE, "agent");
            xb_add(&bar[XB_XGEN(b.x)], 1u);
            asm volatile("s_waitcnt vmcnt(0)" ::: "memory");
        } else {
            XB_SPIN(xb_ld(&bar[XB_XGEN(b.x)]) == gen, bar);
            __builtin_amdgcn_fence(__ATOMIC_ACQUIRE, "agent");
            asm volatile("s_waitcnt vmcnt(0)" ::: "memory");
        }
    }
    __syncthreads();
}


__device__ __forceinline__ void ctx_tile(const Ptrs& P, LAS unsigned char* lds, int tile, int tid, int wave, int lane) {
    unsigned char* ws = P.ws; const int trow = tile >> 3, tcol = tile & 7, r = lane & 31, hh = lane >> 5;
    const bf16_t* A = (const bf16_t*)(ws + WS_H) + (size_t)(MTOK + 32 * trow + r) * DM + 128 * wave + 8 * hh;
    const bf16_t* Bw = (const bf16_t*)(ws + WS_WIN) + (size_t)(tcol < 4 ? 1024 + 32 * tcol + r : 1024 + 64 * tcol + r) * DM + 128 * wave + 8 * hh; const int bstep = tcol < 4 ? 128 : 32;
    f32x16 acc[2];
#pragma unroll
    for (int j = 0; j < 2; ++j)
#pragma unroll
        for (int i = 0; i < 16; ++i) acc[j][i] = 0.f;
#pragma unroll
    for (int ks = 0; ks < 8; ++ks) { const bf16x8_t a = *(const bf16x8_t*)(A + 16 * ks);
#pragma unroll
        for (int j = 0; j < 2; ++j) { const bf16x8_t b = *(const bf16x8_t*)(Bw + (size_t)bstep * j * DM + 16 * ks); acc[j] = MFMA32(a, b, acc[j]); } }
    LAS float* red = (LAS float*)lds;
#pragma unroll
    for (int j = 0; j < 2; ++j)
#pragma unroll
        for (int i = 0; i < 16; ++i) red[(wave * 32 + j * 16 + i) * 64 + lane] = acc[j][i];
    LDS_WAIT(); __builtin_amdgcn_s_barrier(); asm volatile("" ::: "memory");
    {
        const int row = tid >> 4, c = (tid & 15) * 4, cb = c >> 5, i = (row & 3) + 4 * (row >> 3), ln = (c & 31) + 32 * ((row >> 2) & 1);
        f32x4 s = {0.f, 0.f, 0.f, 0.f};
#pragma unroll
        for (int w = 0; w < 8; ++w) s += *(const LAS f32x4*)(red + (w * 32 + cb * 16 + i) * 64 + ln);
        const int crow_ = 32 * trow + row, b = crow_ >> 8, t = crow_ & 255;
        if (tcol < 4) {
            float q = (s[0] * s[0] + s[1] * s[1]) + (s[2] * s[2] + s[3] * s[3]);
            q += __shfl_xor(q, 1); q += __shfl_xor(q, 2); q += __shfl_xor(q, 4); q += __shfl_xor(q, 8);
            const int pj = c & 31, dk = 32 * cb + 16 * ((pj >> 2) & 1) + 4 * (pj >> 3);
            const float rstd = __builtin_amdgcn_rsqf(q * (1.0f / 64.0f) + EPS); const f32x4 g = *(const f32x4*)(P.kg + dk);
            u32x2 w; w.x = cvtpk(s[0] * rstd * g[0], s[1] * rstd * g[1]); w.y = cvtpk(s[2] * rstd * g[2], s[3] * rstd * g[3]);
            *(u32x2*)((bf16_t*)(ws + WS_KC) + (size_t)crow_ * KVW + tcol * 64 + dk) = w;
        } else {
            bf16_t* p = (bf16_t*)(ws + WS_VCT) + ((size_t)((b * 4 + (tcol - 4)) * 64 + c)) * CTX + perm16(t);
#pragma unroll
            for (int k = 0; k < 4; ++k) p[(size_t)k * CTX] = (bf16_t)(cvtpk(s[k], 0.f) & 0xffffu);
        }
    }
    LDS_WAIT(); __builtin_amdgcn_s_barrier(); asm volatile("" ::: "memory");
}
__device__ __forceinline__ void mk_p2(const Ptrs& P, LAS unsigned char* lds, int tid, int wave, int lane, int bx, int G, bool dry) {
    unsigned char* ws = P.ws; (void)tid; (void)wave; (void)lane;
    bf16_t *WIN = (bf16_t*)(ws + WS_WIN), *H = (bf16_t*)(ws + WS_H), *Q = (bf16_t*)(ws + WS_Q), *GATES = (bf16_t*)(ws + WS_GATES), *PG = (bf16_t*)(ws + WS_PG);
    const float* MOD = (const float*)(ws + WS_MOD); float* SSQ = (float*)(ws + WS_SSQ); (void)WIN; (void)H; (void)Q; (void)GATES; (void)PG; (void)MOD; (void)SSQ;
        EpiInRest rest{(bf16_t*)(ws + WS_VT), (bf16_t*)(ws + WS_POOLIN), GATES, P.gate_b}; EpiCtxV cv{(bf16_t*)(ws + WS_VCT)};
        for (int t = bx; t < 256; t += G) ctx_tile(P, lds, t, tid, wave, lane);
        { pg8::Gemm g{H, WIN, MTOK, INW, DM}; pg8::StaticOrder S; S.init(MTOK, INW, G, bx);
          EpiInF<false> E{Q, (bf16_t*)(ws + WS_K), (bf16_t*)(ws + WS_KC), P.qg, P.kg, rest, cv, (LAS float*)(lds + RING_BYTES)};
          pg8::gemm_phase<EpiInF<false>, pg8::StaticOrder, true, true>(lds, g, S, E); }
}
__device__ __forceinline__ void mk_p3(const Ptrs& P, LAS unsigned char* lds, int tid, int wave, int lane, int bx, int G, bool dry) {
    unsigned char* ws = P.ws; (void)tid; (void)wave; (void)lane;
    bf16_t *WIN = (bf16_t*)(ws + WS_WIN), *H = (bf16_t*)(ws + WS_H), *Q = (bf16_t*)(ws + WS_Q), *GATES = (bf16_t*)(ws + WS_GATES), *PG = (bf16_t*)(ws + WS_PG);
    const float* MOD = (const float*)(ws + WS_MOD); float* SSQ = (float*)(ws + WS_SSQ); (void)WIN; (void)H; (void)Q; (void)GATES; (void)PG; (void)MOD; (void)SSQ;
        { bool pre = false; for (int u = bx; u < NB * 32 * 4; u += G) pre = attn_unit(P, lds, u, tid, wave, lane, pre, u + G < NB * 32 * 4 ? u + G : -1); }
        pool_units(P, lds, bx, G, tid, wave, lane);
#if MK_DBL == 8
        for (int u = bx; u < (MTOK / 128) * 4; u += G) pool_unit(P, lds, u, tid, wave, lane);
#endif
}
__device__ __forceinline__ void mk_p4(const Ptrs& P, LAS unsigned char* lds, int tid, int wave, int lane, int bx, int G, bool dry) {
    unsigned char* ws = P.ws; (void)tid; (void)wave; (void)lane;
    bf16_t *WIN = (bf16_t*)(ws + WS_WIN), *H = (bf16_t*)(ws + WS_H), *Q = (bf16_t*)(ws + WS_Q), *GATES = (bf16_t*)(ws + WS_GATES), *PG = (bf16_t*)(ws + WS_PG);
    const float* MOD = (const float*)(ws + WS_MOD); float* SSQ = (float*)(ws + WS_SSQ); (void)WIN; (void)H; (void)Q; (void)GATES; (void)PG; (void)MOD; (void)SSQ;
        { pg8::Gemm g{(bf16_t*)(ws + WS_ATT), (bf16_t*)(ws + WS_WAP), MTOK, DM, DM, (bf16_t*)(ws + WS_PM), (bf16_t*)(ws + WS_WPP), POOLW}; SegOrder S; S.init(MTOK, DM, G, bx);
          EpiMerge E{PG, GATES}; pg8::gemm_phase<EpiMerge, SegOrder, true, true>(lds, g, S, E); }
}
__device__ __forceinline__ void mk_p5(const Ptrs& P, LAS unsigned char* lds, int tid, int wave, int lane, int bx, int G, bool dry) {
    unsigned char* ws = P.ws; (void)tid; (void)wave; (void)lane;
    bf16_t *WIN = (bf16_t*)(ws + WS_WIN), *H = (bf16_t*)(ws + WS_H), *Q = (bf16_t*)(ws + WS_Q), *GATES = (bf16_t*)(ws + WS_GATES), *PG = (bf16_t*)(ws + WS_PG);
    const float* MOD = (const float*)(ws + WS_MOD); float* SSQ = (float*)(ws + WS_SSQ); (void)WIN; (void)H; (void)Q; (void)GATES; (void)PG; (void)MOD; (void)SSQ;
        pg8::Gemm g{PG, (bf16_t*)(ws + WS_WOUT), MTOK, DM, DM}; pg8::StaticOrder S; S.init(MTOK, DM, G, bx);
        EpiOutF E{EpiOut{P.x, P.out, (bf16_t*)(ws + WS_Y2), MOD, P.n2g}, SSQ, (LAS float*)(lds + RING_BYTES)}; pg8::gemm_phase<EpiOutF, pg8::StaticOrder, true, true>(lds, g, S, E);
}
__device__ __forceinline__ void mk_p6(const Ptrs& P, LAS unsigned char* lds, int tid, int wave, int lane, int bx, int G, bool dry) {
    unsigned char* ws = P.ws; (void)tid; (void)wave; (void)lane;
    bf16_t *WIN = (bf16_t*)(ws + WS_WIN), *H = (bf16_t*)(ws + WS_H), *Q = (bf16_t*)(ws + WS_Q), *GATES = (bf16_t*)(ws + WS_GATES), *PG = (bf16_t*)(ws + WS_PG);
    const float* MOD = (const float*)(ws + WS_MOD); float* SSQ = (float*)(ws + WS_SSQ); (void)WIN; (void)H; (void)Q; (void)GATES; (void)PG; (void)MOD; (void)SSQ;
        pg8::Gemm g{(bf16_t*)(ws + WS_Y2), (bf16_t*)(ws + WS_WUP), MTOK, NUP, DM}; pg8::StaticOrder S; S.init(MTOK, NUP, G, bx);
        EpiUpF E{EpiUp{(bf16_t*)(ws + WS_ACT), (const float*)(ws + WS_B2)}, SSQ}; pg8::gemm_phase<EpiUpF, pg8::StaticOrder, true, true>(lds, g, S, E);
}
__device__ __forceinline__ void mk_p7(const Ptrs& P, LAS unsigned char* lds, int tid, int wave, int lane, int bx, int G, bool dry) {
    unsigned char* ws = P.ws; (void)tid; (void)wave; (void)lane;
    bf16_t *WIN = (bf16_t*)(ws + WS_WIN), *H = (bf16_t*)(ws + WS_H), *Q = (bf16_t*)(ws + WS_Q), *GATES = (bf16_t*)(ws + WS_GATES), *PG = (bf16_t*)(ws + WS_PG);
    const float* MOD = (const float*)(ws + WS_MOD); float* SSQ = (float*)(ws + WS_SSQ); (void)WIN; (void)H; (void)Q; (void)GATES; (void)PG; (void)MOD; (void)SSQ;
        pg8::Gemm g{(bf16_t*)(ws + WS_ACT), (bf16_t*)(ws + WS_WDN), MTOK, DM, FF}; pg8::StaticOrder S; S.init(MTOK, DM, G, bx);
        EpiDownF E{EpiDown{P.out, MOD, dry ? (float*)(ws + WS_Y2) : nullptr}}; pg8::gemm_phase<EpiDownF, pg8::StaticOrder, true, true>(lds, g, S, E);
}

#ifndef MK_MASK
#define MK_MASK_ 0xff
#else
#define MK_MASK_ MK_MASK
#endif
__global__ void __launch_bounds__(NTHR, 2) mk_fwd(MkArgs a) {
    extern __shared__ __attribute__((aligned(16))) unsigned char lds_raw[];
    LAS unsigned char* lds = (LAS unsigned char*)lds_raw;
    cg::grid_group grid = cg::this_grid();
    const Ptrs& P = a.P;
    const int tid = threadIdx.x, lane = tid & 63, wave = __builtin_amdgcn_readfirstlane(tid >> 6), bx = blockIdx.x, G = gridDim.x;
    const int lo = a.ph_lo, hi = a.ph_hi;
#ifndef MK_MASK
#define MK_MASK 0xff
#endif
#define IN(k) (((MK_MASK >> (k)) & 1) && lo <= (k) && (k) < hi)
    volatile LAS unsigned* bst = (volatile LAS unsigned*)(lds + 147456);
    if (tid < 2) bst[tid] = 0u;
    if (((MK_MASK_ >> 2) & 1) && a.ph_lo <= 2 && 2 < a.ph_hi) {
        for (int i = tid; i < 1024; i += NTHR) { const int pos = i >> 4, f = i & 15; const float ang = (float)pos * exp2f(-(float)f * (13.287712379549449f / 16.0f));
            ((LAS float*)(lds + RING_BYTES))[2048 + i] = cosf(ang); ((LAS float*)(lds + RING_BYTES))[3072 + i] = sinf(ang); }
    }
    __syncthreads();
    const XcdBarrier xbar = xcd_barrier_post((unsigned*)P.ws, bst);
    if (lo < 0) grid.sync();
#define GRID_SYNC() xcd_barrier(xbar)
#define SEAM(k) do { if (IN(k) && IN((k) + 1)) GRID_SYNC(); } while (0)
    for (int i = 0; i < MK_SYNCX; ++i) GRID_SYNC();
    if (IN(0)) { mk_p0(P, lds, tid, wave, lane, bx, G);
#if MK_DBL == 0
        GRID_SYNC(); mk_p0(P, lds, tid, wave, lane, bx, G);
#endif
    }
    SEAM(0);
    if (IN(1)) { mk_p1(P, wave, lane, bx, G);
#if MK_DBL == 1
        GRID_SYNC(); mk_p1(P, wave, lane, bx, G);
#endif
    }
    SEAM(1);
    if (IN(2)) { mk_p2(P, lds, tid, wave, lane, bx, G, false);
#if MK_DBL == 2
        GRID_SYNC(); mk_p2(P, lds, tid, wave, lane, bx, G, true);
#endif
    }
    SEAM(2);
    if (IN(3)) { mk_p3(P, lds, tid, wave, lane, bx, G, false);
#if MK_DBL == 3
        GRID_SYNC(); mk_p3(P, lds, tid, wave, lane, bx, G, true);
#endif
    }
    SEAM(3);
    if (IN(4)) { mk_p4(P, lds, tid, wave, lane, bx, G, false);
#if MK_DBL == 4
        GRID_SYNC(); mk_p4(P, lds, tid, wave, lane, bx, G, true);
#endif
    }
    SEAM(4);
    if (IN(5)) { mk_p5(P, lds, tid, wave, lane, bx, G, false);
#if MK_DBL == 5
        GRID_SYNC(); mk_p5(P, lds, tid, wave, lane, bx, G, true);
#endif
    }
    SEAM(5);
    if (IN(6)) { mk_p6(P, lds, tid, wave, lane, bx, G, false);
#if MK_DBL == 6
        GRID_SYNC(); mk_p6(P, lds, tid, wave, lane, bx, G, true);
#endif
    }
    SEAM(6);
    if (IN(7)) { mk_p7(P, lds, tid, wave, lane, bx, G, false);
#if MK_DBL == 7
        GRID_SYNC(); mk_p7(P, lds, tid, wave, lane, bx, G, true);
#endif
    }
    SEAM(7);
#undef IN
#undef SEAM
}

static int mk_grid() {
    static int grid = 0;
    if (grid == 0) {
        int dev = 0, cus = 0, per_cu = 0;
        if (hipGetDevice(&dev) != hipSuccess || hipDeviceGetAttribute(&cus, hipDeviceAttributeMultiprocessorCount, dev) != hipSuccess) { fprintf(stderr, "mk_grid: device query failed\n"); grid = -1; return grid; }
        if (hipFuncSetAttribute((const void*)mk_fwd, hipFuncAttributeMaxDynamicSharedMemorySize, LDS_BYTES) != hipSuccess) { fprintf(stderr, "mk_grid: hipFuncSetAttribute failed\n"); grid = -1; return grid; }
        if (hipOccupancyMaxActiveBlocksPerMultiprocessor(&per_cu, (const void*)mk_fwd, NTHR, LDS_BYTES) != hipSuccess || per_cu < 1) { fprintf(stderr, "mk_grid: occupancy query says %d\n", per_cu); (void)hipGetLastError(); per_cu = 1; }
        grid = cus * 1;
    }
    return grid;
}
static void mk_launch(const Ptrs& P, int lo, int hi, hipStream_t stream) {
    const int grid = mk_grid(); if (grid <= 0) return;
    if (hipMemsetAsync(P.ws, 0, 16384, stream) != hipSuccess) { fprintf(stderr, "memset of the barrier words failed\n"); return; }
    MkArgs a{}; a.P = P; a.ph_lo = lo; a.ph_hi = hi;
    void* args[] = {&a};
    hipError_t e = hipLaunchCooperativeKernel((const void*)mk_fwd, dim3(grid), dim3(NTHR), args, LDS_BYTES, stream);
    if (e != hipSuccess) fprintf(stderr, "cooperative launch failed: %s (grid %d)\n", hipGetErrorString(e), grid);
}

extern "C" void kernel_launch(void* const* d_in, const int* in_sizes, int n_in, void* d_out, int out_size, void* d_ws, size_t ws_size, hipStream_t stream) {
    if (n_in != 20 || out_size != MTOK * DM || ws_size < 256 * MiB) { fprintf(stderr, "kernel_launch: unexpected shapes (n_in %d out %d ws %zu)\n", n_in, out_size, ws_size); return; }
    Ptrs P{};
    const float** pp = (const float**)&P;
    for (int i = 0; i < 20; ++i) pp[i] = (const float*)d_in[i];
    P.out = (float*)d_out; P.ws = (unsigned char*)d_ws;
    unsigned char* ws = P.ws;
    bf16_t *WIN = (bf16_t*)(ws + WS_WIN), *WAP = (bf16_t*)(ws + WS_WAP), *WPP = (bf16_t*)(ws + WS_WPP), *WOUT = (bf16_t*)(ws + WS_WOUT), *WUP = (bf16_t*)(ws + WS_WUP), *WDN = (bf16_t*)(ws + WS_WDN), *PW = (bf16_t*)(ws + WS_PW);
    bf16_t *H = (bf16_t*)(ws + WS_H), *Q = (bf16_t*)(ws + WS_Q), *VT = (bf16_t*)(ws + WS_VT), *VCT = (bf16_t*)(ws + WS_VCT), *POOLIN = (bf16_t*)(ws + WS_POOLIN), *GATES = (bf16_t*)(ws + WS_GATES);
    bf16_t *PG = (bf16_t*)(ws + WS_PG), *DIFF = (bf16_t*)(ws + WS_DIFF), *PM = (bf16_t*)(ws + WS_PM), *Y2 = (bf16_t*)(ws + WS_Y2), *ACT = (bf16_t*)(ws + WS_ACT);
    float *MOD = (float*)(ws + WS_MOD), *B2 = (float*)(ws + WS_B2), *SSQ = (float*)(ws + WS_SSQ);
    if (MK_LO == 0) mk_launch(P, 0, MK_HI, stream);
    if (MK_LO > 0) {   mk_launch(P, 0, 2, stream); }
    if (MK_LO == 2) mk_launch(P, MK_LO, MK_HI, stream);
    if (2 < MK_LO || 2 >= MK_HI) {
    k_qk<<<(MTOK / 64 * 20 + 3) / 4, 256, 0, stream>>>(P, 0);
    k_qk<<<(MCTX / 64 * 4 + 3) / 4, 256, 0, stream>>>(P, 1);
    { EpiInRest E{VT, POOLIN, GATES, P.gate_b}; k_gemm<EpiInRest><<<(MTOK / 64 * ((INW - 1280) / 8) + 3) / 4, 256, 0, stream>>>(H, DM, WIN + (size_t)1280 * DM, DM, MTOK, INW - 1280, DM, 1280, E); }
    { EpiCtxV E{VCT}; k_gemm<EpiCtxV><<<(MCTX / 64 * (KVW / 8) + 3) / 4, 256, 0, stream>>>(H + (size_t)MTOK * DM, DM, WIN + (size_t)1280 * DM, DM, MCTX, KVW, DM, 0, E); }
    }
    if (MK_LO == 3) mk_launch(P, MK_LO, MK_HI, stream);
    if (3 < MK_LO || 3 >= MK_HI) {
    k_attn<<<(MTOK / 64 * 16 + 3) / 4, 256, 0, stream>>>(P);
    k_diff<<<(MTOK * POOLW + 255) / 256, 256, 0, stream>>>(POOLIN, DIFF);
    for (int g = 0; g < 4; ++g) { EpiPoolMix E{PM, P.pool_scale, g}; k_gemm<EpiPoolMix><<<(MTOK / 64 * (128 / 8) + 3) / 4, 256, 0, stream>>>(DIFF + g * 128, POOLW, PW + g * 16384, 128, MTOK, 128, 128, 0, E); }
    }
    if (MK_LO == 4) mk_launch(P, MK_LO, MK_HI, stream);
    if (4 < MK_LO || 4 >= MK_HI) {
    { EpiPoolProj E{PG, GATES}; k_gemm<EpiPoolProj><<<(MTOK / 64 * (DM / 8) + 3) / 4, 256, 0, stream>>>(PM, PMP, WPP, PMP, MTOK, DM, POOLW, 0, E); }
    { EpiAttnProj E{PG, GATES}; k_gemm<EpiAttnProj><<<(MTOK / 64 * (DM / 8) + 3) / 4, 256, 0, stream>>>((bf16_t*)(ws + WS_ATT), DM, WAP, DM, MTOK, DM, DM, 0, E); }
    }
    if (MK_LO == 5) mk_launch(P, MK_LO, MK_HI, stream);
    if (5 < MK_LO || 5 >= MK_HI) {
    { EpiOut E{P.x, P.out, Y2, MOD, P.n2g}; k_gemm_out<<<(MTOK / 64 * (DM / 8) + 3) / 4, 256, 0, stream>>>(PG, WOUT, E); }
    k_ssq<<<(MTOK * 4 + 255) / 256, 256, 0, stream>>>(P.out, SSQ);
    }
    if (MK_LO == 6) mk_launch(P, MK_LO, MK_HI, stream);
    if (6 < MK_LO || 6 >= MK_HI) {
    { EpiUp E{ACT, B2}; k_gemm_up<<<(MTOK / 64 * (FF / 8) + 3) / 4, 256, 0, stream>>>(Y2, WUP, SSQ, E); }
    }
    if (MK_LO == 7) mk_launch(P, MK_LO, MK_HI, stream);
    if (7 < MK_LO || 7 >= MK_HI) {
    { EpiDown E{P.out, MOD}; k_gemm<EpiDown><<<(MTOK / 64 * (DM / 8) + 3) / 4, 256, 0, stream>>>(ACT, FF, WDN, FF, MTOK, DM, FF, 0, E); }
    }
}
```
